# Optimizing an MI355X kernel written in HIP

```python
import math
import jax, jax.numpy as jnp
from jax import lax
import numpy as np

D_MODEL = 1024
BATCH = 2
SEQ = 8192
DEPTH = 1

PLE_DIM = 256
DIFF_HEADS = 4
DIFF_HEAD_DIM = 64
DIFF_WIDTH = DIFF_HEADS * 2 * DIFF_HEAD_DIM
MOBA_HEADS = 8
MOBA_HEAD_DIM = 64
MOBA_WIDTH = MOBA_HEADS * MOBA_HEAD_DIM
MOBA_BLOCK = 256
MOBA_TOPK = 3
ROT_DIM = 16
ROPE_THETA = 500000.0
Q_CHUNK = 128
N_BRANCHES = 2
IN_COLS = 4 * DIFF_WIDTH + 4 * MOBA_WIDTH + N_BRANCHES * D_MODEL
EPS = 1e-6
SUBLN_EPS = 1e-5

kernel_name = "hybrid_diffattn_moba_gated_block"


def rms_norm(x, g, eps=EPS):
    xf = x.astype(jnp.float32)
    y = xf * lax.rsqrt(jnp.mean(xf * xf, axis=-1, keepdims=True) + eps)
    return (y * g.astype(jnp.float32)).astype(x.dtype)


def rope_tables(seq):
    inv = ROPE_THETA ** (-jnp.arange(0, ROT_DIM, 2, dtype=jnp.float32) / ROT_DIM)
    ang = jnp.arange(seq, dtype=jnp.float32)[:, None] * inv[None, :]
    return jnp.cos(ang), jnp.sin(ang)


def partial_rope(x, cos, sin):
    half = ROT_DIM // 2
    shape = (1, cos.shape[0]) + (1,) * (x.ndim - 3) + (half,)
    c = cos.reshape(shape).astype(x.dtype)
    s = sin.reshape(shape).astype(x.dtype)
    x1 = x[..., :half]
    x2 = x[..., half:ROT_DIM]
    rot = jnp.concatenate([x1 * c - x2 * s, x2 * c + x1 * s], axis=-1)
    return jnp.concatenate([rot, x[..., ROT_DIM:]], axis=-1)


def split_in_proj(proj):
    sizes = (DIFF_WIDTH,) * 4 + (MOBA_WIDTH,) * 4 + (N_BRANCHES * D_MODEL,)
    idx = []
    acc = 0
    for s in sizes[:-1]:
        acc += s
        idx.append(acc)
    return jnp.split(proj, idx, axis=-1)


def diff_attention(q, k, v, lam, lam_init, subln_g):
    B, S, H, _, dh = q.shape
    n_chunks = S // Q_CHUNK
    scale = dh ** -0.5
    key_pos = jnp.arange(S)
    qc = q.reshape(B, n_chunks, Q_CHUNK, H, 2, dh).transpose(1, 0, 2, 3, 4, 5)

    def one_chunk(args):
        c, q_blk = args
        s = jnp.einsum('bqhmd,bkhmd->bhmqk', q_blk, k).astype(jnp.float32) * scale
        q_pos = c * Q_CHUNK + jnp.arange(Q_CHUNK)
        s = jnp.where(key_pos[None, :] <= q_pos[:, None], s, -jnp.inf)
        a = jax.nn.softmax(s, axis=-1)
        w = a[:, :, 0] - lam * a[:, :, 1]
        return jnp.einsum('bhqk,bkhe->bqhe', w.astype(v.dtype), v)

    o = lax.map(one_chunk, (jnp.arange(n_chunks), qc))
    o = o.transpose(1, 0, 2, 3, 4).reshape(B, S, H, 2 * dh)
    o = rms_norm(o, subln_g, SUBLN_EPS) * (1.0 - lam_init)
    return o.reshape(B, S, H * 2 * dh)


def moba_attention(q, k, v):
    B, S, H, dh = q.shape
    nb = -(-S // MOBA_BLOCK)
    pad = nb * MOBA_BLOCK - S
    kp = jnp.pad(k, ((0, 0), (0, pad), (0, 0), (0, 0)))
    vp = jnp.pad(v, ((0, 0), (0, pad), (0, 0), (0, 0)))
    k_blocks = kp.reshape(B, nb, MOBA_BLOCK, H, dh).transpose(0, 3, 1, 2, 4)
    v_blocks = vp.reshape(B, nb, MOBA_BLOCK, H, dh).transpose(0, 3, 1, 2, 4)
    k_mean = jnp.mean(k_blocks.astype(jnp.float32), axis=3).astype(k.dtype)
    topk = min(MOBA_TOPK, nb)
    scale = dh ** -0.5
    n_chunks = S // Q_CHUNK
    qc = q.reshape(B, n_chunks, Q_CHUNK, H, dh).transpose(1, 0, 3, 2, 4)
    b_idx = jnp.arange(B)[:, None, None, None]
    h_idx = jnp.arange(H)[None, :, None, None]
    blk_ids = jnp.arange(nb)

    def one_chunk(args):
        c, q_blk = args
        q_start = c * Q_CHUNK
        own = q_start // MOBA_BLOCK
        q_pos = q_start + jnp.arange(Q_CHUNK)
        gate = jnp.einsum('bhqd,bhnd->bhqn', q_blk, k_mean).astype(jnp.float32)
        gate = jnp.where(blk_ids < own, gate, -jnp.inf)
        _, sel = lax.top_k(gate, topk)
        sel_valid = jnp.arange(topk) < own
        k_sel = k_blocks[b_idx, h_idx, sel]
        v_sel = v_blocks[b_idx, h_idx, sel]
        s_sel = jnp.einsum('bhqd,bhqrkd->bhqrk', q_blk, k_sel).astype(jnp.float32) * scale
        s_sel = jnp.where(sel_valid[:, None], s_sel, -jnp.inf).reshape(B, H, Q_CHUNK, topk * MOBA_BLOCK)
        k_own = lax.dynamic_index_in_dim(k_blocks, own, axis=2, keepdims=False)
        v_own = lax.dynamic_index_in_dim(v_blocks, own, axis=2, keepdims=False)
        s_own = jnp.einsum('bhqd,bhkd->bhqk', q_blk, k_own).astype(jnp.float32) * scale
        own_pos = own * MOBA_BLOCK + jnp.arange(MOBA_BLOCK)
        s_own = jnp.where(own_pos[None, :] <= q_pos[:, None], s_own, -jnp.inf)
        pr = jax.nn.softmax(jnp.concatenate([s_sel, s_own], axis=-1), axis=-1).astype(v.dtype)
        p_sel = pr[..., :topk * MOBA_BLOCK].reshape(B, H, Q_CHUNK, topk, MOBA_BLOCK)
        p_own = pr[..., topk * MOBA_BLOCK:]
        return (jnp.einsum('bhqrk,bhqrkd->bhqd', p_sel, v_sel)
                + jnp.einsum('bhqk,bhkd->bhqd', p_own, v_own))

    o = lax.map(one_chunk, (jnp.arange(n_chunks), qc))
    return o.transpose(1, 0, 3, 2, 4).reshape(B, S, H * dh)


def setup_inputs(seed: int = 0) -> dict:
    key = jax.random.key(seed)
    ks = jax.random.split(key, 16)
    f32 = jnp.float32
    nrm = lambda k, shape, sc: jax.random.normal(k, shape, f32) * sc
    return {
        'x': nrm(ks[0], (BATCH, SEQ, D_MODEL), 1.0),
        'p': nrm(ks[1], (DEPTH, BATCH, SEQ, PLE_DIM), 1.0),
        'norm_g': 1.0 + nrm(ks[2], (DEPTH, D_MODEL), 0.02),
        'w_in': nrm(ks[3], (DEPTH, D_MODEL, IN_COLS), D_MODEL ** -0.5),
        'lambda_q1': nrm(ks[4], (DEPTH, DIFF_HEAD_DIM), 0.1),
        'lambda_k1': nrm(ks[5], (DEPTH, DIFF_HEAD_DIM), 0.1),
        'lambda_q2': nrm(ks[6], (DEPTH, DIFF_HEAD_DIM), 0.1),
        'lambda_k2': nrm(ks[7], (DEPTH, DIFF_HEAD_DIM), 0.1),
        'subln_g': 1.0 + nrm(ks[8], (DEPTH, 2 * DIFF_HEAD_DIM), 0.02),
        'w_branch_diff': nrm(ks[9], (DEPTH, DIFF_WIDTH, D_MODEL), DIFF_WIDTH ** -0.5),
        'w_branch_moba': nrm(ks[10], (DEPTH, MOBA_WIDTH, D_MODEL), MOBA_WIDTH ** -0.5),
        'w_out': nrm(ks[11], (DEPTH, D_MODEL, D_MODEL), D_MODEL ** -0.5),
        'w_ple': nrm(ks[12], (DEPTH, PLE_DIM, D_MODEL), PLE_DIM ** -0.5),
        'w_ple_gate': nrm(ks[13], (DEPTH, D_MODEL, D_MODEL), D_MODEL ** -0.5),
        'final_g': 1.0 + nrm(ks[14], (D_MODEL,), 0.02),
    }


def reference(x, p, norm_g, w_in, lambda_q1, lambda_k1, lambda_q2, lambda_k2, subln_g,
              w_branch_diff, w_branch_moba, w_out, w_ple, w_ple_gate, final_g):
    B, S, _ = x.shape
    cos, sin = rope_tables(S)
    for i in range(DEPTH):
        lam_init = 0.8 - 0.6 * math.exp(-0.3 * i)
        h = rms_norm(x, norm_g[i])
        proj = h @ w_in[i]
        dq, dk, dv, dg, mq, mk, mv, mg, gates = split_in_proj(proj)
        dq = partial_rope(dq.reshape(B, S, DIFF_HEADS, 2, DIFF_HEAD_DIM), cos, sin)
        dk = partial_rope(dk.reshape(B, S, DIFF_HEADS, 2, DIFF_HEAD_DIM), cos, sin)
        dv = dv.reshape(B, S, DIFF_HEADS, 2 * DIFF_HEAD_DIM)
        lam = (jnp.exp(jnp.sum(lambda_q1[i].astype(jnp.float32) * lambda_k1[i].astype(jnp.float32)))
               - jnp.exp(jnp.sum(lambda_q2[i].astype(jnp.float32) * lambda_k2[i].astype(jnp.float32)))
               + lam_init)
        o_a = diff_attention(dq, dk, dv, lam, lam_init, subln_g[i]) * jax.nn.silu(dg)
        y_a = o_a @ w_branch_diff[i]
        mq = partial_rope(mq.reshape(B, S, MOBA_HEADS, MOBA_HEAD_DIM), cos, sin)
        mk = partial_rope(mk.reshape(B, S, MOBA_HEADS, MOBA_HEAD_DIM), cos, sin)
        mv = mv.reshape(B, S, MOBA_HEADS, MOBA_HEAD_DIM)
        o_b = moba_attention(mq, mk, mv) * jax.nn.silu(mg)
        y_b = o_b @ w_branch_moba[i]
        g_a, g_b = jnp.split(gates, N_BRANCHES, axis=-1)
        merged = jax.nn.sigmoid(g_a) * y_a + jax.nn.sigmoid(g_b) * y_b
        x = x + merged @ w_out[i]
        x = x + jax.nn.sigmoid(x @ w_ple_gate[i]) * (p[i] @ w_ple[i])
    return rms_norm(x, final_g)
```

```cpp
#include <hip/hip_runtime.h>
#include <hip/hip_cooperative_groups.h>
#include <cstdio>
#include <cstdint>
namespace cg = cooperative_groups;
template <int K> __device__ __forceinline__ float swz_xor(float v) { return __int_as_float(__builtin_amdgcn_ds_swizzle(__float_as_int(v), 0x1f | (K << 10))); }
__device__ __forceinline__ float half_sum(float v) { auto rr = __builtin_amdgcn_permlane32_swap(__float_as_uint(v), __float_as_uint(v), false, false); return __uint_as_float(rr[0]) + __uint_as_float(rr[1]); }
__device__ __forceinline__ int lane_id_opaque() { unsigned m = ~0u; asm volatile("" : "+s"(m)); return (int)__builtin_amdgcn_mbcnt_hi(m, __builtin_amdgcn_mbcnt_lo(m, 0u)); }
namespace pg8 {
#define PG8_LAS __attribute__((address_space(3)))
typedef unsigned short bf16_t;
typedef short bf16x8 __attribute__((ext_vector_type(8)));
typedef float f32x4 __attribute__((ext_vector_type(4)));
typedef unsigned u32x4 __attribute__((ext_vector_type(4)));
constexpr int BM = 256, BK = 64, HALF = 128, HTB = HALF * BK * 2  , STAGE_BYTES = 8 * HTB, NXCD = 8, WGM = 8;

__host__ __device__ __forceinline__ int lds_byte(int r, int c) { const int st = (r >> 4) * 2 + (c >> 5), rr = r & 15, cc = c & 31, ob = rr * 64 + cc * 2; return st * 1024 + (ob ^ (((ob >> 9) & 1) << 5)); }
__host__ __device__ __forceinline__ void stage_rc(int b, int& R, int& C) { const int st = b / 1024, sb = b % 1024, swz = sb ^ (((sb >> 9) & 1) << 5); R = (st >> 1) * 16 + swz / 64; C = (st & 1) * 32 + (swz % 64) / 2; }
__host__ __device__ __forceinline__ int perm32(int rho) { const int n = rho >> 4, i = rho & 15; return 8 * (i >> 2) + 4 * n + (i & 3); }

struct Unit { int pm, pn, g; };
struct Gemm { const bf16_t* A0; const bf16_t* B0t; const bf16_t* A1; const bf16_t* B1t; int M, N, K; };

struct StaticOrder {
    int nM, nN, nwg, G, c, fx, fpm, fpn;
    __host__ __device__ void init(int M, int N, int G_, int c_) { nM = M / BM; nN = N / BM; nwg = nM * nN; G = G_; c = c_; fx = 0; fpm = 0; fpn = 0; }
    __host__ __device__ void fix(int pm, int pn) { fx = 1; fpm = pm; fpn = pn; }
    __host__ __device__ bool next(int i, Unit& u) const {
        if (fx) { if (i >= 1) return false; u.pm = fpm; u.pn = fpn; u.g = 0; return true; }
        const long L = (long)i * G + c; if (L >= nwg) return false;
        int wgid = (int)L; { const int q = nwg / NXCD, r = nwg % NXCD, xcd = wgid % NXCD, off = wgid / NXCD; wgid = (xcd < r ? xcd * (q + 1) : r * (q + 1) + (xcd - r) * q) + off; }
        const int nig = WGM * nN, gid = wgid / nig, fm = gid * WGM, gsz = (nM - fm) < WGM ? (nM - fm) : WGM;
        u.pm = fm + ((wgid % nig) % gsz); u.pn = (wgid % nig) / gsz; u.g = 0; return true;
    }
    __device__ __forceinline__ void a_ready(const Unit&) const {}
    __device__ __forceinline__ void done(const Unit&) const {}
};

__device__ __forceinline__ unsigned cvt_pk_bf16(float lo, float hi) { unsigned r; asm volatile("v_cvt_pk_bf16_f32 %0, %1, %2" : "=v"(r) : "v"(lo), "v"(hi)); return r; }
__device__ __forceinline__ float bf_lo(unsigned w) { return __uint_as_float(w << 16); }
__device__ __forceinline__ float bf_hi(unsigned w) { return __uint_as_float(w & 0xffff0000u); }
__device__ __forceinline__ float sigmoid_f(float v) { return __builtin_amdgcn_rcpf(1.0f + __expf(-v)); }
__device__ __forceinline__ f32x4 sigmoid4(f32x4 v) { return (f32x4){sigmoid_f(v[0]), sigmoid_f(v[1]), sigmoid_f(v[2]), sigmoid_f(v[3])}; }
typedef unsigned u32x2 __attribute__((ext_vector_type(2)));

struct EpiInProj {
    static constexpr bool PERM = true, AFTER_DRAIN = false, CHAIN = false;
    unsigned char* seg0;
    unsigned char* gseg0;
    const float* rope;
    float* kmean;
    float qscale;
    __device__ __forceinline__ void operator()(f32x4 (&acc)[2][2][4][2], const Unit& u, int wr, int wc, int fr, int fq) const {
        const int pn = u.pn; bf16_t* base; int ldc, colt, mode; float sc = 1.f;
        if (pn < 16) { const int seg = pn >> 1; base = (bf16_t*)(seg0 + (size_t)seg * (16u << 20)); ldc = 512; colt = (pn & 1) * 256;
            mode = (seg == 0 || seg == 1 || seg == 4 || seg == 5) ? 1 : ((seg == 3 || seg == 7) ? 2 : 0); if (seg == 0 || seg == 4) sc = qscale; }
        else { base = (bf16_t*)(gseg0 + (size_t)((pn - 16) >> 2) * (32u << 20)); ldc = 1024; colt = ((pn - 16) & 3) * 256; mode = 3; }
        const int row0 = u.pm * BM + wr * 64 + fr, col0 = colt + wc * 32 + 8 * fq;
        if (mode == 1 && (wc & 1) == 0) {
            const float sgn = (fq == 0) ? -1.f : ((fq == 1) ? 1.f : 0.f); const bool rot = fq < 2;
#pragma unroll
            for (int ai = 0; ai < 2; ++ai)
#pragma unroll
                for (int m = 0; m < 4; ++m) { const int t = (row0 + ai * HALF + m * 16) & 8191; const f32x4* tp = (const f32x4*)(rope + (size_t)t * 16);
                    f32x4 cs[2], sn[2]; cs[0] = tp[0]; cs[1] = tp[1]; sn[0] = tp[2]; sn[1] = tp[3];
#pragma unroll
                    for (int bj = 0; bj < 2; ++bj)
#pragma unroll
                        for (int n = 0; n < 2; ++n) { f32x4 v = acc[ai][bj][m][n], p;
                            p[0] = swz_xor<16>(v[0]); p[1] = swz_xor<16>(v[1]); p[2] = swz_xor<16>(v[2]); p[3] = swz_xor<16>(v[3]);
                            const f32x4 o = v * cs[n] + (p * sn[n]) * sgn; acc[ai][bj][m][n] = rot ? o : v; } }
        }
        if (pn == 10 || pn == 11) {
            const int b = u.pm >> 5, nblk = u.pm & 31;
#pragma unroll
            for (int bj = 0; bj < 2; ++bj)
#pragma unroll
                for (int n = 0; n < 2; ++n) { f32x4 s = (f32x4){0.f, 0.f, 0.f, 0.f};
#pragma unroll
                    for (int ai = 0; ai < 2; ++ai)
#pragma unroll
                        for (int m = 0; m < 4; ++m) s += acc[ai][bj][m][n];
#pragma unroll
                    for (int j = 0; j < 4; ++j) { float x = s[j]; x += swz_xor<1>(x); x += swz_xor<2>(x); x += swz_xor<4>(x); x += swz_xor<8>(x);
                        if (fr == 0) { const int cg_ = (pn - 10) * 256 + bj * HALF + wc * 32 + 8 * fq + 4 * n + j; atomicAdd(kmean + ((size_t)((b * 8 + (cg_ >> 6)) * 32 + nblk)) * 64 + (cg_ & 63), x * (1.0f / 256.0f)); } } }
        }
#pragma unroll
        for (int ai = 0; ai < 2; ++ai)
#pragma unroll
            for (int m = 0; m < 4; ++m) { bf16_t* rowp = base + (size_t)(row0 + ai * HALF + m * 16) * ldc + col0;
#pragma unroll
                for (int bj = 0; bj < 2; ++bj) { f32x4 v0 = acc[ai][bj][m][0], v1 = acc[ai][bj][m][1];
                    if (mode == 2) { v0 = v0 * sigmoid4(v0); v1 = v1 * sigmoid4(v1); }
                    else if (mode == 3) { v0 = sigmoid4(v0); v1 = sigmoid4(v1); }
                    v0 = v0 * sc; v1 = v1 * sc; u32x4 w; w.x = cvt_pk_bf16(v0[0], v0[1]); w.y = cvt_pk_bf16(v0[2], v0[3]); w.z = cvt_pk_bf16(v1[0], v1[1]); w.w = cvt_pk_bf16(v1[2], v1[3]);
                    if (mode >= 2) __builtin_nontemporal_store(w, (u32x4*)(rowp + bj * HALF)); else *(u32x4*)(rowp + bj * HALF) = w; } }
    }
};
struct EpiStore {
    static constexpr bool PERM = true, AFTER_DRAIN = false, CHAIN = false;
    bf16_t* O; int ldc; int tstride;
    __device__ __forceinline__ void operator()(f32x4 (&acc)[2][2][4][2], const Unit& u, int wr, int wc, int fr, int fq) const {
        const int row0 = u.pm * BM + wr * 64 + fr, col0 = u.pn * tstride + wc * 32 + 8 * fq;
#pragma unroll
        for (int ai = 0; ai < 2; ++ai)
#pragma unroll
            for (int m = 0; m < 4; ++m) { bf16_t* rowp = O + (size_t)(row0 + ai * HALF + m * 16) * ldc + col0;
#pragma unroll
                for (int bj = 0; bj < 2; ++bj) { const f32x4 v0 = acc[ai][bj][m][0], v1 = acc[ai][bj][m][1];
                    u32x4 w; w.x = cvt_pk_bf16(v0[0], v0[1]); w.y = cvt_pk_bf16(v0[2], v0[3]); w.z = cvt_pk_bf16(v1[0], v1[1]); w.w = cvt_pk_bf16(v1[2], v1[3]);
                    *(u32x4*)(rowp + bj * HALF) = w; } }
    }
};
struct EpiMerge {
    static constexpr bool PERM = true, AFTER_DRAIN = false, CHAIN = true;
    const bf16_t* SA; const bf16_t* SB; bf16_t* O;
    __device__ __forceinline__ void operator()(f32x4 (&acc)[2][2][4][2], const Unit& u, int wr, int wc, int fr, int fq) const {
        const int row0 = u.pm * BM + wr * 64 + fr, col0 = u.pn * BM + wc * 32 + 8 * fq;
#pragma unroll
        for (int ai = 0; ai < 2; ++ai)
#pragma unroll
            for (int m = 0; m < 4; ++m) { const size_t off = (size_t)(row0 + ai * HALF + m * 16) * 1024 + col0;
#pragma unroll
                for (int bj = 0; bj < 2; ++bj) { const u32x4 b = *(const u32x4*)(SB + off + bj * HALF);
                    const f32x4 b0 = (f32x4){bf_lo(b.x), bf_hi(b.x), bf_lo(b.y), bf_hi(b.y)}, b1 = (f32x4){bf_lo(b.z), bf_hi(b.z), bf_lo(b.w), bf_hi(b.w)};
                    if (u.g == 0) { const u32x4 a = *(const u32x4*)(SA + off + bj * HALF);
                        const f32x4 a0 = (f32x4){bf_lo(a.x), bf_hi(a.x), bf_lo(a.y), bf_hi(a.y)}, a1 = (f32x4){bf_lo(a.z), bf_hi(a.z), bf_lo(a.w), bf_hi(a.w)};
                        f32x4 r0, r1;
#pragma unroll
                        for (int j = 0; j < 4; ++j) { r0[j] = a0[j] * __builtin_amdgcn_rcpf(b0[j]); r1[j] = a1[j] * __builtin_amdgcn_rcpf(b1[j]); }
                        acc[ai][bj][m][0] *= r0; acc[ai][bj][m][1] *= r1; }
                    else { const f32x4 v0 = acc[ai][bj][m][0] * b0, v1 = acc[ai][bj][m][1] * b1;
                        u32x4 w; w.x = cvt_pk_bf16(v0[0], v0[1]); w.y = cvt_pk_bf16(v0[2], v0[3]); w.z = cvt_pk_bf16(v1[0], v1[1]); w.w = cvt_pk_bf16(v1[2], v1[3]);
                        *(u32x4*)(O + off + bj * HALF) = w; } }
                asm volatile("" ::: "memory"); }
    }
};
template <bool WRITE_F32> struct EpiResid {
    static constexpr bool PERM = false, AFTER_DRAIN = false, CHAIN = false;
    const float* X; float* out; bf16_t* xb;
    __device__ __forceinline__ void operator()(f32x4 (&acc)[2][2][4][2], const Unit& u, int wr, int wc, int fr, int fq) const {
        const int col0 = u.pn * BM + wc * 32 + 4 * fq;
#pragma unroll
        for (int ai = 0; ai < 2; ++ai)
#pragma unroll
            for (int m = 0; m < 4; ++m) { const size_t off = (size_t)(u.pm * BM + ai * HALF + wr * 64 + m * 16 + fr) * 1024 + col0;
#pragma unroll
                for (int bj = 0; bj < 2; ++bj)
#pragma unroll
                    for (int n = 0; n < 2; ++n) { const size_t o2 = off + bj * HALF + n * 16; const f32x4 v = __builtin_nontemporal_load((const f32x4*)(X + o2)) + acc[ai][bj][m][n];
                        if (WRITE_F32) *(f32x4*)(out + o2) = v; u32x2 w; w.x = cvt_pk_bf16(v[0], v[1]); w.y = cvt_pk_bf16(v[2], v[3]); *(u32x2*)(xb + o2) = w; } }
    }
};
struct EpiPle {
    static constexpr bool PERM = false, AFTER_DRAIN = false, CHAIN = false;
    float* out; const bf16_t* ple;
    __device__ __forceinline__ void operator()(f32x4 (&acc)[2][2][4][2], const Unit& u, int wr, int wc, int fr, int fq) const {
        const int col0 = u.pn * BM + wc * 32 + 4 * fq;
#pragma unroll
        for (int ai = 0; ai < 2; ++ai)
#pragma unroll
            for (int m = 0; m < 4; ++m) { const size_t off = (size_t)(u.pm * BM + ai * HALF + wr * 64 + m * 16 + fr) * 1024 + col0;
#pragma unroll
                for (int bj = 0; bj < 2; ++bj)
#pragma unroll
                    for (int n = 0; n < 2; ++n) { const size_t o2 = off + bj * HALF + n * 16; const u32x2 pw = __builtin_nontemporal_load((const u32x2*)(ple + o2));
                        const f32x4 pl = (f32x4){bf_lo(pw.x), bf_hi(pw.x), bf_lo(pw.y), bf_hi(pw.y)};
                        const f32x4 v = *(const f32x4*)(out + o2) + sigmoid4(acc[ai][bj][m][n]) * pl; *(f32x4*)(out + o2) = v; } }
    }
};
struct EpiPleNorm {
    static constexpr bool PERM = false, AFTER_DRAIN = true, CHAIN = false;
    float* out; const bf16_t* x1b; const bf16_t* ple; const float* fg; float* xbuf; unsigned* cnt;
    __device__ __forceinline__ void operator()(f32x4 (&acc)[2][2][4][2], const Unit& u, int wr, int wc, int fr, int fq) const {}
    __device__ __forceinline__ void fused(f32x4 (&acc)[2][2][4][2], const Unit& u, int wr, int wc, int fr, int fq, PG8_LAS unsigned char* lds, int wid, int lane) const {
        PG8_LAS float* P = (PG8_LAS float*)lds;
        PG8_LAS float* S = (PG8_LAS float*)(lds + 4096);
        const int col0 = u.pn * BM + wc * 32 + 4 * fq;
#pragma unroll
        for (int ai = 0; ai < 2; ++ai)
#pragma unroll
            for (int m = 0; m < 4; ++m) { const size_t off = (size_t)(u.pm * BM + ai * HALF + wr * 64 + m * 16 + fr) * 1024 + col0;
#pragma unroll
                for (int bj = 0; bj < 2; ++bj)
#pragma unroll
                    for (int n = 0; n < 2; ++n) { const size_t o2 = off + bj * HALF + n * 16; const u32x2 pw = __builtin_nontemporal_load((const u32x2*)(ple + o2 + (off - col0) + u.pn * BM));
                        const f32x4 pl = (f32x4){bf_lo(pw.x), bf_hi(pw.x), bf_lo(pw.y), bf_hi(pw.y)};
                        const u32x2 xw = *(const u32x2*)(x1b + o2); const f32x4 x1 = (f32x4){bf_lo(xw.x), bf_hi(xw.x), bf_lo(xw.y), bf_hi(xw.y)};
                        acc[ai][bj][m][n] = x1 + sigmoid4(acc[ai][bj][m][n]) * pl; }
                asm volatile("" : "+v"(acc[ai][0][m][0]), "+v"(acc[ai][0][m][1]), "+v"(acc[ai][1][m][0]), "+v"(acc[ai][1][m][1]));
                if (m & 1) asm volatile("" ::: "memory"); }
#pragma unroll
        for (int ai = 0; ai < 2; ++ai)
#pragma unroll
            for (int m = 0; m < 4; ++m) { float s = 0.f;
#pragma unroll
                for (int bj = 0; bj < 2; ++bj)
#pragma unroll
                    for (int n = 0; n < 2; ++n) { const f32x4 x = acc[ai][bj][m][n]; s += (x[0] * x[0] + x[1] * x[1]) + (x[2] * x[2] + x[3] * x[3]); }
                s += swz_xor<16>(s); s = half_sum(s);
                if (fq == 0) P[(ai * HALF + wr * 64 + m * 16 + fr) * 4 + wc] = s; }
        asm volatile("s_waitcnt lgkmcnt(0)" ::: "memory"); __builtin_amdgcn_s_barrier(); asm volatile("" ::: "memory");
        const int row = wid * 32 + (lane & 31);
        if (lane < 32) { const float t = (P[row * 4 + 0] + P[row * 4 + 1]) + (P[row * 4 + 2] + P[row * 4 + 3]);
            __hip_atomic_store(xbuf + (size_t)(u.pm * BM + row) * 4 + u.pn, t, __ATOMIC_RELAXED, __HIP_MEMORY_SCOPE_AGENT); }
        asm volatile("s_waitcnt vmcnt(0)" ::: "memory");
        if (lane == 0) __hip_atomic_fetch_add(cnt + 64 * u.pm, 1u, __ATOMIC_RELAXED, __HIP_MEMORY_SCOPE_AGENT);
        if (wid == 0) { unsigned sp = 0;
            while ((unsigned)__builtin_amdgcn_readfirstlane(__hip_atomic_load(cnt + 64 * u.pm, __ATOMIC_RELAXED, __HIP_MEMORY_SCOPE_AGENT)) < 32u) { __builtin_amdgcn_s_sleep(2); if (++sp > (1u << 22)) break; }
            __builtin_amdgcn_fence(__ATOMIC_ACQUIRE, "agent"); }
        asm volatile("s_waitcnt vmcnt(0) lgkmcnt(0)" ::: "memory"); __builtin_amdgcn_s_barrier(); asm volatile("" ::: "memory");
        if (lane < 32) { const float* slot = xbuf + (size_t)(u.pm * BM + row) * 4; float q = 0.f;
#pragma unroll
            for (int t = 0; t < 4; ++t) q += __hip_atomic_load(slot + t, __ATOMIC_RELAXED, __HIP_MEMORY_SCOPE_AGENT);
            S[row] = 1.0f / sqrtf(q * (1.0f / 1024.0f) + 1e-6f); }
        asm volatile("s_waitcnt lgkmcnt(0)" ::: "memory"); __builtin_amdgcn_s_barrier(); asm volatile("" ::: "memory");
        f32x4 gv[2][2];
#pragma unroll
        for (int bj = 0; bj < 2; ++bj)
#pragma unroll
            for (int n = 0; n < 2; ++n) gv[bj][n] = *(const f32x4*)(fg + col0 + bj * HALF + n * 16);
#pragma unroll
        for (int ai = 0; ai < 2; ++ai)
#pragma unroll
            for (int m = 0; m < 4; ++m) { const int r = ai * HALF + wr * 64 + m * 16 + fr; const float rs = S[r]; const size_t off = (size_t)(u.pm * BM + r) * 1024 + col0;
#pragma unroll
                for (int bj = 0; bj < 2; ++bj)
#pragma unroll
                    for (int n = 0; n < 2; ++n) __builtin_nontemporal_store(acc[ai][bj][m][n] * rs * gv[bj][n], (f32x4*)(out + off + bj * HALF + n * 16)); }
    }
};
struct PairOrder {
    StaticOrder s;
    __host__ __device__ void init(int M, int N, int G_, int c_) { s.init(M, N, G_, c_); }
    __host__ __device__ bool next(int i, Unit& u) const { if (!s.next(i >> 1, u)) return false; u.g = i & 1; return true; }
    __device__ __forceinline__ void a_ready(const Unit&) const {}
    __device__ __forceinline__ void done(const Unit&) const {}
};
template <class Epi, class Sched, bool ALIGN_EPI = false, bool SP2 = false>
__device__ __forceinline__ void gemm_phase(PG8_LAS unsigned char* lds, const Gemm g, const Sched& S, const Epi& E, int wv_) {
    int tid_ = wv_ * 64 + lane_id_opaque(); asm volatile("" : "+v"(tid_));
    const int tid = tid_, wid = __builtin_amdgcn_readfirstlane(tid >> 6), lane = tid & 63, wr = wid >> 2, wc = wid & 3, fr = lane & 15, fq = lane >> 4;
    const int K = g.K, nt = K / BK;
    unsigned voffA[2], voffB[2];
#pragma unroll
    for (int i = 0; i < 2; ++i) { int R, C; stage_rc(tid * 16 + i * 8192, R, C); const int Rb = Epi::PERM ? ((R & ~31) + perm32(R & 31)) : R;
        voffA[i] = (unsigned)(R * K + C) * 2u; voffB[i] = (unsigned)(Rb * K + C) * 2u; }
    const size_t kstep = (size_t)(BK * 2);
    const size_t hstep = (size_t)HALF * K * 2;
    const size_t tstep = 2 * hstep;
    const unsigned ldsw = (unsigned)wid * 1024u;
    const int aoff = lds_byte(wr * 64 + fr, fq * 8), boff = lds_byte(wc * 32 + fr, fq * 8);
#define PG8_SA(b, h) (((b) * 2 + (h)) * HTB)
#define PG8_SB(b, h) ((4 + (b) * 2 + (h)) * HTB)
#define PG8_STAGE(bufoff, gbase, voff) do { _Pragma("unroll") for (int _i = 0; _i < 2; ++_i) \
        __builtin_amdgcn_global_load_lds((const unsigned*)((const char*)(gbase) + (voff)[_i]), (PG8_LAS unsigned*)(lds + (bufoff) + ldsw + _i * 8192), 16, 0, 0); } while (0)
#define PG8_LDA(dst, b, h) do { _Pragma("unroll") for (int m = 0; m < 4; ++m) _Pragma("unroll") for (int k = 0; k < 2; ++k) dst[m][k] = *(const PG8_LAS bf16x8*)(lds + PG8_SA(b, h) + aoff + m * 2048 + k * 1024); } while (0)
#define PG8_LDB(dst, b, h) do { _Pragma("unroll") for (int n = 0; n < 2; ++n) _Pragma("unroll") for (int k = 0; k < 2; ++k) dst[n][k] = *(const PG8_LAS bf16x8*)(lds + PG8_SB(b, h) + boff + n * 2048 + k * 1024); } while (0)
#define PG8_MMA(ai, bj, At, Bt) do { __builtin_amdgcn_s_setprio(1); _Pragma("unroll") for (int m = 0; m < 4; ++m) _Pragma("unroll") for (int n = 0; n < 2; ++n) _Pragma("unroll") for (int k = 0; k < 2; ++k) \
        acc[ai][bj][m][n] = __builtin_amdgcn_mfma_f32_16x16x32_bf16(Bt[n][k], At[m][k], acc[ai][bj][m][n], 0, 0, 0); __builtin_amdgcn_s_setprio(0); } while (0)
#define PG8_WAIT_V(n) asm volatile("s_waitcnt vmcnt(" #n ")" ::: "memory")
#define PG8_WAIT_L(n) asm volatile("s_waitcnt lgkmcnt(" #n ")" ::: "memory")
#define PG8_BAR __builtin_amdgcn_s_barrier()
#define PG8_SCHED __builtin_amdgcn_sched_barrier(0)
    Unit cur, nxt; int ui = 0;
    if (!S.next(0, cur)) return;
    f32x4 acc[2][2][4][2];
#pragma unroll
    for (int a = 0; a < 2; ++a)
#pragma unroll
        for (int b = 0; b < 2; ++b)
#pragma unroll
            for (int m = 0; m < 4; ++m)
#pragma unroll
                for (int n = 0; n < 2; ++n) acc[a][b][m][n] = (f32x4){0.f, 0.f, 0.f, 0.f};
    bf16x8 At[4][2], B0[2][2], B1[2][2];
    const char* cA = (const char*)(cur.g ? g.A1 : g.A0) + (size_t)cur.pm * tstep; const char* cB = (const char*)(cur.g ? g.B1t : g.B0t) + (size_t)cur.pn * tstep;
    S.a_ready(cur);
    if constexpr (SP2) {
        PG8_STAGE(PG8_SB(0, 0), cB, voffB); PG8_STAGE(PG8_SB(0, 1), cB + hstep, voffB); PG8_STAGE(PG8_SA(0, 0), cA, voffA); PG8_STAGE(PG8_SA(0, 1), cA + hstep, voffA);
        if (wr == 1) PG8_BAR;
        PG8_WAIT_V(2); PG8_BAR;
        PG8_STAGE(PG8_SB(1, 0), cB + kstep, voffB); PG8_STAGE(PG8_SA(1, 0), cA + kstep, voffA); PG8_STAGE(PG8_SB(1, 1), cB + hstep + kstep, voffB);
        PG8_WAIT_V(6); PG8_BAR;
    } else {
        PG8_STAGE(PG8_SB(0, 0), cB, voffB); PG8_STAGE(PG8_SA(0, 0), cA, voffA); PG8_STAGE(PG8_SB(0, 1), cB + hstep, voffB); PG8_STAGE(PG8_SA(0, 1), cA + hstep, voffA);
        if (wr == 1) PG8_BAR;
        PG8_WAIT_V(4); PG8_BAR;
        PG8_STAGE(PG8_SB(1, 0), cB + kstep, voffB); PG8_STAGE(PG8_SA(1, 0), cA + kstep, voffA); PG8_STAGE(PG8_SB(1, 1), cB + hstep + kstep, voffB);
        PG8_WAIT_V(6); PG8_BAR;
    }
    for (;;) {
        const bool has_next = S.next(ui + 1, nxt);
        const char* nA = has_next ? (const char*)(nxt.g ? g.A1 : g.A0) + (size_t)nxt.pm * tstep : cA; const char* nB = has_next ? (const char*)(nxt.g ? g.B1t : g.B0t) + (size_t)nxt.pn * tstep : cB;
        for (int t = 0; t < nt; t += 2) {
            const bool last = (t == nt - 2);
            const char* a1 = cA + (size_t)(t + 1) * kstep;
            const char* a2 = last ? nA : cA + (size_t)(t + 2) * kstep; const char* b2 = last ? nB : cB + (size_t)(t + 2) * kstep;
            const char* a3 = a2 + kstep; const char* b3 = b2 + kstep;
            if (last && has_next) S.a_ready(nxt);
            if constexpr (SP2) {
            PG8_LDB(B0, 0, 0); PG8_LDB(B1, 0, 1); PG8_SCHED; PG8_LDA(At, 0, 0); PG8_STAGE(PG8_SA(1, 1), a1 + hstep, voffA);
            PG8_WAIT_V(8); PG8_WAIT_L(0); PG8_BAR; PG8_MMA(0, 0, At, B0); PG8_MMA(0, 1, At, B1); PG8_BAR; PG8_SCHED;
            PG8_LDA(At, 0, 1); PG8_STAGE(PG8_SB(0, 0), b2, voffB); PG8_STAGE(PG8_SB(0, 1), b2 + hstep, voffB); PG8_STAGE(PG8_SA(0, 0), a2, voffA);
            PG8_WAIT_V(8); PG8_WAIT_L(0); PG8_BAR; PG8_MMA(1, 0, At, B0); PG8_MMA(1, 1, At, B1); PG8_BAR; PG8_SCHED;
            PG8_LDB(B0, 1, 0); PG8_LDB(B1, 1, 1); PG8_SCHED; PG8_LDA(At, 1, 0); PG8_STAGE(PG8_SA(0, 1), a2 + hstep, voffA);
            PG8_WAIT_V(8); PG8_WAIT_L(0); PG8_BAR; PG8_MMA(0, 0, At, B0); PG8_MMA(0, 1, At, B1); PG8_BAR; PG8_SCHED;
            PG8_LDA(At, 1, 1); PG8_STAGE(PG8_SB(1, 0), b3, voffB); PG8_STAGE(PG8_SB(1, 1), b3 + hstep, voffB); PG8_STAGE(PG8_SA(1, 0), a3, voffA);
            PG8_WAIT_V(8); PG8_WAIT_L(0); PG8_BAR; PG8_MMA(1, 0, At, B0); PG8_MMA(1, 1, At, B1); PG8_BAR; PG8_SCHED;
            } else {
            PG8_LDB(B0, 0, 0); PG8_SCHED; PG8_LDA(At, 0, 0); PG8_STAGE(PG8_SA(1, 1), a1 + hstep, voffA);
            PG8_WAIT_L(8); PG8_BAR; PG8_WAIT_L(0); PG8_MMA(0, 0, At, B0); PG8_BAR; PG8_SCHED;
            PG8_LDB(B1, 0, 1); PG8_STAGE(PG8_SB(0, 0), b2, voffB);
            PG8_BAR; PG8_WAIT_L(0); PG8_MMA(0, 1, At, B1); PG8_BAR;
            PG8_LDA(At, 0, 1); PG8_STAGE(PG8_SA(0, 0), a2, voffA);
            PG8_BAR; PG8_WAIT_L(0); PG8_MMA(1, 0, At, B0); PG8_BAR; PG8_SCHED;
            PG8_STAGE(PG8_SB(0, 1), b2 + hstep, voffB);
            PG8_WAIT_V(6); PG8_BAR; PG8_MMA(1, 1, At, B1); PG8_BAR;
            PG8_LDB(B0, 1, 0); PG8_SCHED; PG8_LDA(At, 1, 0); PG8_STAGE(PG8_SA(0, 1), a2 + hstep, voffA);
            PG8_WAIT_L(8); PG8_BAR; PG8_WAIT_L(0); PG8_MMA(0, 0, At, B0); PG8_BAR; PG8_SCHED;
            PG8_LDB(B1, 1, 1); PG8_STAGE(PG8_SB(1, 0), b3, voffB);
            PG8_BAR; PG8_WAIT_L(0); PG8_MMA(0, 1, At, B1); PG8_BAR;
            PG8_LDA(At, 1, 1); PG8_STAGE(PG8_SA(1, 0), a3, voffA);
            PG8_BAR; PG8_WAIT_L(0); PG8_MMA(1, 0, At, B0); PG8_BAR; PG8_SCHED;
            PG8_STAGE(PG8_SB(1, 1), b3 + hstep, voffB);
            PG8_WAIT_V(6); PG8_BAR; PG8_MMA(1, 1, At, B1); PG8_BAR;
            }
        }
        if constexpr (ALIGN_EPI) { if (wr == 0) PG8_BAR; }
        if constexpr (!Epi::AFTER_DRAIN) { E(acc, cur, wr, wc, fr, fq); S.done(cur); }
        if (!has_next) break;
        if (!(Epi::CHAIN && cur.g == 0)) {
#pragma unroll
        for (int a = 0; a < 2; ++a)
#pragma unroll
            for (int b = 0; b < 2; ++b)
#pragma unroll
                for (int m = 0; m < 4; ++m)
#pragma unroll
                    for (int n = 0; n < 2; ++n) acc[a][b][m][n] = (f32x4){0.f, 0.f, 0.f, 0.f};
        }
        cur = nxt; cA = nA; cB = nB; ++ui;
        if constexpr (ALIGN_EPI) { if (wr == 1) PG8_BAR; }
    }
    PG8_WAIT_V(0);
    if constexpr (!ALIGN_EPI) { if (wr == 0) PG8_BAR; }
    PG8_BAR;
    if constexpr (Epi::AFTER_DRAIN) { E.fused(acc, cur, wr, wc, fr, fq, lds, wid, lane); S.done(cur); }
#undef PG8_SA
#undef PG8_SB
#undef PG8_STAGE
#undef PG8_LDA
#undef PG8_LDB
#undef PG8_MMA
#undef PG8_WAIT_V
#undef PG8_WAIT_L
#undef PG8_BAR
#undef PG8_SCHED
}
}
#include <hip/hip_bf16.h>
#include <cmath>
namespace attn_body {
using bf16=__hip_bfloat16;
using bf16x8=__attribute__((ext_vector_type(8)))short;
using s16x4=__attribute__((ext_vector_type(4)))short;
using f32x16=__attribute__((ext_vector_type(16)))float;
using u32x4=__attribute__((ext_vector_type(4)))unsigned;
using f32x4_t=__attribute__((ext_vector_type(4)))float;
constexpr int BATCH=2,SEQ=8192,D=64,DM=512;
constexpr int NW=8,QBLK=32,QB=QBLK*NW,KVBLK=64,NQB=SEQ/QB;
constexpr int ATTN_PITCH=DM, ATTN_UNIT_ROWS=QB;
__device__ __forceinline__ int crow(int r,int hi){return (r&3)+8*(r>>2)+4*hi;}
#define SBAR() __builtin_amdgcn_sched_barrier(0)
__device__ __forceinline__ void cmask(f32x16&p0,f32x16&p1,int jb,int qrel,int hi){
  const float NEG=-INFINITY; int kb=64*jb+4*hi;
  #pragma unroll
  for(int r=0;r<16;++r){int kv=kb+(r&3)+8*(r>>2); if(kv>qrel)p0[r]=NEG; if(kv+32>qrel)p1[r]=NEG;}
}

constexpr int NSLOT=3, SLOTB=8192;
constexpr int LDS_K=0, LDS_V=NSLOT*SLOTB, LDS_V2=2*NSLOT*SLOTB, LDS_WS=3*NSLOT*SLOTB, LDS_OST=LDS_WS+NW*64*4, LDS_BYTES=LDS_OST+NW*4096;
constexpr float C2=0.125f*1.4426950408889634f;
__device__ __forceinline__ void glds16(const void*gsrc,unsigned lds_dst){unsigned keep;
  asm volatile("s_mov_b32 %0, m0\n\ts_mov_b32 m0, %2\n\ts_nop 0\n\tglobal_load_lds_dwordx4 %1, off\n\ts_mov_b32 m0, %0":"=&s"(keep):"v"(gsrc),"s"(lds_dst):"memory");}
__device__ __forceinline__ float max3f(float a,float b,float c){float r;asm("v_max3_f32 %0, %1, %2, %3":"=v"(r):"v"(a),"v"(b),"v"(c));return r;}
__device__ __forceinline__ float max2f(float a,float b){float r;asm("v_max_f32_e32 %0, %1, %2":"=v"(r):"v"(a),"v"(b));return r;}
__device__ __forceinline__ float fadd_s(float a,float b){float r;asm("v_add_f32_e32 %0, %1, %2":"=v"(r):"v"(a),"v"(b));return r;}
__device__ __forceinline__ float fsub_s(float a,float b){float r;asm("v_sub_f32_e32 %0, %1, %2":"=v"(r):"v"(a),"v"(b));return r;}
typedef float f32x2_t __attribute__((ext_vector_type(2))); typedef __bf16 bf16x2_t __attribute__((ext_vector_type(2)));
__device__ __forceinline__ unsigned cvtpk_s(float lo,float hi){f32x2_t v={lo,hi};bf16x2_t b=__builtin_convertvector(v,bf16x2_t);return __builtin_bit_cast(unsigned,b);}
#define WAIT_BAR(N) asm volatile("s_waitcnt vmcnt(" #N ") lgkmcnt(0)\n\ts_barrier":::"memory")

__device__ __forceinline__ void qkt(f32x16&p0,f32x16&p1,const char*Kslot,const bf16x8*qr,const f32x16&negm,int r32,int hi){
  const char*kb=Kslot+hi*1024+r32*16;
  #pragma unroll
  for(int d0=0;d0<4;++d0){
    const bf16x8 b0=*reinterpret_cast<const bf16x8*>(kb+d0*2048);
    const bf16x8 b1=*reinterpret_cast<const bf16x8*>(kb+d0*2048+512);
    if(d0==0){p0=__builtin_amdgcn_mfma_f32_32x32x16_bf16(b0,qr[0],negm,0,0,0);p1=__builtin_amdgcn_mfma_f32_32x32x16_bf16(b1,qr[0],negm,0,0,0);}
    else{p0=__builtin_amdgcn_mfma_f32_32x32x16_bf16(b0,qr[d0],p0,0,0,0);p1=__builtin_amdgcn_mfma_f32_32x32x16_bf16(b1,qr[d0],p1,0,0,0);}}
}
typedef __attribute__((address_space(3))) const char* lds_cptr;
typedef short v4i16_t __attribute__((ext_vector_type(4)));
__device__ __forceinline__ void kload8(bf16x8*kf,lds_cptr kp){
  kf[0]=*(const __attribute__((address_space(3))) bf16x8*)(kp);      kf[1]=*(const __attribute__((address_space(3))) bf16x8*)(kp+512);
  kf[2]=*(const __attribute__((address_space(3))) bf16x8*)(kp+2048); kf[3]=*(const __attribute__((address_space(3))) bf16x8*)(kp+2560);
  kf[4]=*(const __attribute__((address_space(3))) bf16x8*)(kp+4096); kf[5]=*(const __attribute__((address_space(3))) bf16x8*)(kp+4608);
  kf[6]=*(const __attribute__((address_space(3))) bf16x8*)(kp+6144); kf[7]=*(const __attribute__((address_space(3))) bf16x8*)(kp+6656);
}
__device__ __forceinline__ void kload2(bf16x8*kf,lds_cptr kp,int j){ kf[2*j]=*(const __attribute__((address_space(3))) bf16x8*)(kp+j*2048); kf[2*j+1]=*(const __attribute__((address_space(3))) bf16x8*)(kp+j*2048+512); }
__device__ __forceinline__ s16x4 vtr(lds_cptr p){ return __builtin_bit_cast(s16x4,__builtin_amdgcn_ds_read_tr16_b64_v4i16((__attribute__((address_space(3))) v4i16_t*)p)); }
__device__ __forceinline__ float rowmax(const f32x16&p0,const f32x16&p1){
  float a=max3f(p0[0],p0[1],p1[0]),b=max3f(p0[2],p0[3],p1[1]);a=max3f(a,p1[2],p1[3]);
  #pragma unroll
  for(int r=4;r<16;r+=4){a=max3f(a,p0[r],p0[r+1]);b=max3f(b,p0[r+2],p0[r+3]);a=max3f(a,p1[r],p1[r+1]);b=max3f(b,p1[r+2],p1[r+3]);}
  const float m=max2f(a,b);
  auto rr=__builtin_amdgcn_permlane32_swap(__float_as_uint(m),__float_as_uint(m),false,false);
  return max2f(__uint_as_float(rr[0]),__uint_as_float(rr[1]));
}
__device__ __forceinline__ void pv(f32x16*o,int vb,bf16x8 pa0,bf16x8 pa1,bf16x8 pa2,bf16x8 pa3){
  #pragma unroll
  for(int d0=0;d0<2;++d0){s16x4 lo[4],hi[4];
    #pragma unroll
    for(int ks=0;ks<4;++ks){
      asm volatile("ds_read_b64_tr_b16 %0,%1 offset:%c2":"=&v"(lo[ks]):"v"(vb),"i"(d0*4096+ks*1024):"memory");
      asm volatile("ds_read_b64_tr_b16 %0,%1 offset:%c2":"=&v"(hi[ks]):"v"(vb),"i"(d0*4096+ks*1024+512):"memory");}
    asm volatile("s_waitcnt lgkmcnt(0)":::"memory");SBAR();
    #define PK(k) (bf16x8){lo[k][0],lo[k][1],lo[k][2],lo[k][3],hi[k][0],hi[k][1],hi[k][2],hi[k][3]}
    o[d0]=__builtin_amdgcn_mfma_f32_32x32x16_bf16(pa0,PK(0),o[d0],0,0,0);
    o[d0]=__builtin_amdgcn_mfma_f32_32x32x16_bf16(pa1,PK(1),o[d0],0,0,0);
    o[d0]=__builtin_amdgcn_mfma_f32_32x32x16_bf16(pa2,PK(2),o[d0],0,0,0);
    o[d0]=__builtin_amdgcn_mfma_f32_32x32x16_bf16(pa3,PK(3),o[d0],0,0,0);
    #undef PK
  }
}

#ifndef ATTN_STORE16
#define ATTN_STORE16(p,v) (*(u32x4*)(p)=(v))
#endif
template<int THRL,bool MOBA,bool V128> __device__ __forceinline__ void attn_unit(int qb,const bf16*Qh,const bf16*Kh,const bf16*Vh,bf16*Oh,const bf16*Gh,const float*km,char*shm,int wv_){
  int tid_=wv_*64+lane_id_opaque(); asm volatile("":"+v"(tid_)); const int tid=tid_,lane=tid&63,r32=lane&31,hi=lane>>5; const int wid=__builtin_amdgcn_readfirstlane(tid>>6);
  const int q0=qb*QB;
  const bf16*Qw=Qh+(long)(q0+wid*QBLK)*DM;
  const unsigned lds0=(unsigned)(uintptr_t)shm;
  float*wsf=(float*)(shm+LDS_WS)+wid*64;
  const bf16*ksrc=Kh+(long)lane*DM+wid*8;
  const bf16*vsrc=Vh+(long)(16*(wid&3)+(lane>>2))*DM+(wid>>2)*32+(lane&3)*8;
  const unsigned kdst=lds0+LDS_K+wid*1024, vdst=lds0+LDS_V+wid*1024;
  #define DMA_K(t,slot) glds16(ksrc+(long)(t)*KVBLK*DM,(unsigned)__builtin_amdgcn_readfirstlane(kdst+(slot)))
  #define DMA_V(t,slot) do{ glds16(vsrc+(long)(t)*KVBLK*DM,(unsigned)__builtin_amdgcn_readfirstlane(vdst+(slot))); if constexpr(V128) glds16(vsrc+64+(long)(t)*KVBLK*DM,(unsigned)__builtin_amdgcn_readfirstlane(vdst+(LDS_V2-LDS_V)+(slot))); }while(0)
  #define WAIT_STEP() do{ if constexpr(V128){WAIT_BAR(3);} else {WAIT_BAR(2);} }while(0)
  const int vb0=(int)(lds0+LDS_V)+((lane>>4)&1)*32+(lane&3)*8+(4*hi+((lane&15)>>2))*64;
  const char*Kbase=shm+LDS_K; bf16x8 kf[8];
  const lds_cptr shm3=(lds_cptr)shm; const lds_cptr kp0=shm3+LDS_K+hi*1024+r32*16; const lds_cptr vp0=shm3+LDS_V+((lane>>4)&1)*32+(lane&3)*8+(4*hi+((lane&15)>>2))*64;
  unsigned selm=0u; bool active=true;
  #define MOBA_STAGE() do{ if constexpr(MOBA){ if(tid<qb*16){ const f32x4_t kv_=((const f32x4_t*)km)[tid]; *(__attribute__((address_space(3))) f32x4_t*)(shm3+LDS_OST+tid*16)=kv_; } } }while(0)
  #define MOBA_GATE() do{ if constexpr(MOBA){ \
      float qf[32]; \
      _Pragma("unroll") for(int d0=0;d0<4;++d0) _Pragma("unroll") for(int i=0;i<8;++i) qf[d0*8+i]=__uint_as_float(((unsigned)(unsigned short)qr[d0][i])<<16); \
      float v1=-INFINITY,v2=-INFINITY,v3=-INFINITY; unsigned m1=0u,m2=0u,m3=0u; \
      const __attribute__((address_space(3))) f32x4_t* kml=(const __attribute__((address_space(3))) f32x4_t*)(shm3+LDS_OST)+hi*2; \
      for(int n=0;n<qb;++n){ float g=0.f; \
        _Pragma("unroll") for(int d0=0;d0<4;++d0){ const f32x4_t a_=kml[n*16+d0*4], b_=kml[n*16+d0*4+1]; \
          g+=qf[d0*8+0]*a_.x; g+=qf[d0*8+1]*a_.y; g+=qf[d0*8+2]*a_.z; g+=qf[d0*8+3]*a_.w; g+=qf[d0*8+4]*b_.x; g+=qf[d0*8+5]*b_.y; g+=qf[d0*8+6]*b_.z; g+=qf[d0*8+7]*b_.w; } \
        g=half_sum(g); const unsigned bit=1u<<n; \
        if(g>v1){v3=v2;m3=m2;v2=v1;m2=m1;v1=g;m1=bit;} else if(g>v2){v3=v2;m3=m2;v2=g;m2=bit;} else if(g>v3){v3=g;m3=bit;} } \
      selm=m1|m2|m3|(1u<<qb); active=(selm&1u)!=0u; } }while(0)
  #define MOBA_T0(P0,P1) do{ if constexpr(MOBA){ if(!active){ _Pragma("unroll") for(int r=0;r<16;++r){P0[r]=0.f;P1[r]=0.f;} } } }while(0)
  #define BLK(tt) do{ if constexpr(MOBA){ if((((tt))&3)==0){ active=((selm>>((tt)>>2))&1u)!=0u; const float nv_=active?-mhat:-INFINITY; _Pragma("unroll") for(int r=0;r<16;++r)negm[r]=nv_; asm volatile("":"+v"(negm)); } } }while(0)
  const int NT=(q0+QB)/KVBLK;
  DMA_K(0,0);DMA_V(0,0);DMA_K(1,SLOTB);
  bf16x8 qr[4];
  #pragma unroll
  for(int d0=0;d0<4;++d0)qr[d0]=*reinterpret_cast<const bf16x8*>(&Qw[(long)r32*DM+d0*16+hi*8]);
  float mhat=0.f,l_reg=0.f;f32x16 o[V128?4:2]; _Pragma("unroll") for(int i_=0;i_<(V128?4:2);++i_)o[i_]=f32x16{};f32x16 negm=f32x16{}; if constexpr(true){ float z_=0.f; asm volatile("":"+v"(z_)); _Pragma("unroll") for(int r=0;r<16;++r)negm[r]=z_; asm volatile("":"+v"(negm)); }
  const int qrel=wid*QBLK+r32;
  #define CMASK(P0,P1,t) do{int jb_=(t)-(NT-4); if(jb_>=0)cmask(P0,P1,jb_,qrel,hi);}while(0)
  bool resc=false;
  #define START(P0,P1) do{ const float rm=rowmax(P0,P1); resc=false; \
    { const float dl=rm; mhat=fadd_s(mhat,dl); \
      _Pragma("unroll") for(int r=0;r<16;++r){P0[r]=fsub_s(P0[r],dl);P1[r]=fsub_s(P1[r],dl);} \
      if constexpr(true){ { const float nv_=(MOBA&&!active)?-INFINITY:-mhat; _Pragma("unroll") for(int r=0;r<16;++r)negm[r]=nv_; } asm volatile("":"+v"(negm)); } } \
    _Pragma("unroll") for(int r=0;r<16;++r)P0[r]=__builtin_amdgcn_exp2f(P0[r]); }while(0)
  #define RESC() do{ if(resc){ asm volatile("s_waitcnt lgkmcnt(0)":::"memory"); \
      _Pragma("unroll") for(int d_=0;d_<(V128?4:2);++d_) _Pragma("unroll") for(int r=0;r<16;++r)o[d_][r]*=wsf[crow(r,hi)]; } }while(0)
  f32x16 pA0,pA1,pB0,pB1;
  int sl_prev=0,sl_cur=0,sl_next=SLOTB;
  #define ROT() do{sl_prev=sl_cur;sl_cur=sl_next;sl_next=(sl_next==(NSLOT-1)*SLOTB)?0:sl_next+SLOTB;}while(0)
  DMA_K(2,2*SLOTB);
  MOBA_STAGE();
  WAIT_BAR(3);
  MOBA_GATE();
  qkt(pA0,pA1,Kbase,qr,negm,r32,hi);asm volatile("s_nop 15\n\ts_nop 7":"+v"(pA0),"+v"(pA1));CMASK(pA0,pA1,0);
  START(pA0,pA1);
  _Pragma("unroll") for(int r=0;r<16;++r)pA1[r]=__builtin_amdgcn_exp2f(pA1[r]);
  MOBA_T0(pA0,pA1);
  WAIT_BAR(0);
  DMA_K(3,0);DMA_V(1,SLOTB);
  ROT();
  kload8(kf,kp0+sl_cur);
  WAIT_STEP();
  s16x4 vlo[8],vhi[8]; u32x4 pw0,pw1,pw2,pw3;
  #define PKW(P,B) cvtpk_s(P[B],P[B+1])
  #define PAF(k) __builtin_bit_cast(bf16x8,pw##k)
  #define VFR(i) (bf16x8){vlo[i][0],vlo[i][1],vlo[i][2],vlo[i][3],vhi[i][0],vhi[i][1],vhi[i][2],vhi[i][3]}
  #define PIN(x) asm volatile("":"+v"(x))
  #define MX3(a,b,c) __builtin_fmaxf(__builtin_fmaxf((a),(b)),(c))
  #define GAPA(MF,A0,A1,A2,A3,W0,W1,PW) do{ MF; sacc+=A0; sacc+=A1; sacc+=A2; sacc+=A3; PIN(sacc); W0; W1; PIN(PW); SBAR(); }while(0)
  #define EX(v) __builtin_amdgcn_exp2f(v)
  #define GAPB(MF,X,B) do{ MF; X[B]=EX(X[B]); X[B+1]=EX(X[B+1]); X[B+2]=EX(X[B+2]); X[B+3]=EX(X[B+3]); PIN(X); SBAR(); }while(0)
  #define CINIT negm
  #define GAPB2(MF,X,B) do{ MF; X[B]=EX(X[B]); X[B+1]=EX(X[B+1]); PIN(X); SBAR(); }while(0)
  #define VRDS(s,i,base) do{ vlo[s]=vtr(base+(((i)>>2)*4096+((i)&3)*1024)); vhi[s]=vtr(base+(((i)>>2)*4096+((i)&3)*1024+512)); SBAR(); }while(0)
  #define VFS(s) (bf16x8){vlo[s][0],vlo[s][1],vlo[s][2],vlo[s][3],vhi[s][0],vhi[s][1],vhi[s][2],vhi[s][3]}
  #define VRD(i) do{ if constexpr(V128){ if(((i)&3)<2){ vlo[((i)&3)*2+((i)>>2)]=vtr(vp_+(((i)>>2)*4096+((i)&3)*1024)); vhi[((i)&3)*2+((i)>>2)]=vtr(vp_+(((i)>>2)*4096+((i)&3)*1024+512)); } } else { vlo[i]=vtr(vp_+(((i)>>2)*4096+((i)&3)*1024)); vhi[i]=vtr(vp_+(((i)>>2)*4096+((i)&3)*1024+512)); } }while(0)
  #define KRD(G,j) do{ if(G){ kload2(kf,kp0+sl_next,j); SBAR(); } }while(0)
  #define STEP(C0,C1,P0,P1,t,GK,GV,GL) do{ SBAR(); \
    const lds_cptr vp_=vp0+sl_prev; \
    VRD(0); SBAR(); float sacc=(P0[0]+P0[1]); \
    GAPA(C0=__builtin_amdgcn_mfma_f32_32x32x16_bf16(kf[0],qr[0],CINIT,0,0,0), P0[2],P0[3],P0[4],P0[5],     pw0[0]=PKW(P0,0), pw0[1]=PKW(P0,2), pw0); \
    VRD(4); SBAR(); GAPA(C1=__builtin_amdgcn_mfma_f32_32x32x16_bf16(kf[1],qr[0],CINIT,0,0,0), P0[6],P0[7],P0[8],P0[9],     pw0[2]=PKW(P0,4), pw0[3]=PKW(P0,6), pw0); \
    VRD(1); SBAR(); GAPA(C0=__builtin_amdgcn_mfma_f32_32x32x16_bf16(kf[2],qr[1],C0,0,0,0),   P0[10],P0[11],P0[12],P0[13], pw1[0]=PKW(P0,8), pw1[1]=PKW(P0,10), pw1); \
    VRD(5); SBAR(); GAPA(C1=__builtin_amdgcn_mfma_f32_32x32x16_bf16(kf[3],qr[1],C1,0,0,0),   P0[14],P0[15],P1[0],P1[1],   pw1[2]=PKW(P0,12),pw1[3]=PKW(P0,14), pw1); \
    VRD(2); SBAR(); GAPA(C0=__builtin_amdgcn_mfma_f32_32x32x16_bf16(kf[4],qr[2],C0,0,0,0),   P1[2],P1[3],P1[4],P1[5],     pw2[0]=PKW(P1,0), pw2[1]=PKW(P1,2), pw2); \
    VRD(6); SBAR(); GAPA(C1=__builtin_amdgcn_mfma_f32_32x32x16_bf16(kf[5],qr[2],C1,0,0,0),   P1[6],P1[7],P1[8],P1[9],     pw2[2]=PKW(P1,4), pw2[3]=PKW(P1,6), pw2); \
    VRD(3); SBAR(); GAPA(C0=__builtin_amdgcn_mfma_f32_32x32x16_bf16(kf[6],qr[3],C0,0,0,0),   P1[10],P1[11],P1[12],P1[13], pw3[0]=PKW(P1,8), pw3[1]=PKW(P1,10), pw3); \
    VRD(7); SBAR(); GAPA(C1=__builtin_amdgcn_mfma_f32_32x32x16_bf16(kf[7],qr[3],C1,0,0,0),   P1[14],P1[15],0.f,0.f,       pw3[2]=PKW(P1,12),pw3[3]=PKW(P1,14), pw3); \
    l_reg+=sacc; \
    if(GK){DMA_K((t)+3,sl_cur);} if(GV){DMA_V((t)+1,sl_next);} \
    CMASK(C0,C1,t); \
    { float a=MX3(C0[0],C0[1],C1[0]),b=MX3(C0[2],C0[3],C1[1]); a=MX3(a,C1[2],C1[3]); \
      _Pragma("unroll") for(int r=4;r<16;r+=4){a=MX3(a,C0[r],C0[r+1]);b=MX3(b,C0[r+2],C0[r+3]);a=MX3(a,C1[r],C1[r+1]);b=MX3(b,C1[r+2],C1[r+3]);} \
      float rm=__builtin_fmaxf(a,b); { auto rr=__builtin_amdgcn_permlane32_swap(__float_as_uint(rm),__float_as_uint(rm),false,false); rm=__builtin_fmaxf(__uint_as_float(rr[0]),__uint_as_float(rr[1])); } \
      resc=false; \
      if(__builtin_expect(__any(rm>(float)THRL),0)){ const float dl=__builtin_fmaxf(rm,0.f); mhat+=dl; \
        _Pragma("unroll") for(int r=0;r<16;++r){C0[r]-=dl;C1[r]-=dl;} \
        if constexpr(true){ { const float nv_=(MOBA&&!active)?-INFINITY:-mhat; _Pragma("unroll") for(int r=0;r<16;++r)negm[r]=nv_; } asm volatile("":"+v"(negm)); } \
        const float f=__builtin_amdgcn_exp2f(-dl); l_reg*=f; if(hi==0)wsf[r32]=f; resc=true; } } \
    SBAR(); \
    if constexpr(V128){ const lds_cptr vp2_=vp_+(LDS_V2-LDS_V); \
    GAPB2(o[0]=__builtin_amdgcn_mfma_f32_32x32x16_bf16(PAF(0),VFS(0),o[0],0,0,0), C0,0); VRDS(0,2,vp_); \
    GAPB2(o[1]=__builtin_amdgcn_mfma_f32_32x32x16_bf16(PAF(0),VFS(1),o[1],0,0,0), C0,2); VRDS(1,6,vp_); \
    KRD(GL,0); GAPB2(o[0]=__builtin_amdgcn_mfma_f32_32x32x16_bf16(PAF(1),VFS(2),o[0],0,0,0), C0,4); VRDS(2,3,vp_); \
    KRD(GL,1); GAPB2(o[1]=__builtin_amdgcn_mfma_f32_32x32x16_bf16(PAF(1),VFS(3),o[1],0,0,0), C0,6); VRDS(3,7,vp_); \
    KRD(GL,2); GAPB2(o[0]=__builtin_amdgcn_mfma_f32_32x32x16_bf16(PAF(2),VFS(0),o[0],0,0,0), C0,8); VRDS(0,0,vp2_); \
    KRD(GL,3); GAPB2(o[1]=__builtin_amdgcn_mfma_f32_32x32x16_bf16(PAF(2),VFS(1),o[1],0,0,0), C0,10); VRDS(1,4,vp2_); \
    GAPB2(o[0]=__builtin_amdgcn_mfma_f32_32x32x16_bf16(PAF(3),VFS(2),o[0],0,0,0), C0,12); VRDS(2,1,vp2_); \
    GAPB2(o[1]=__builtin_amdgcn_mfma_f32_32x32x16_bf16(PAF(3),VFS(3),o[1],0,0,0), C0,14); VRDS(3,5,vp2_); \
    GAPB2(o[2]=__builtin_amdgcn_mfma_f32_32x32x16_bf16(PAF(0),VFS(0),o[2],0,0,0), C1,0); VRDS(0,2,vp2_); \
    GAPB2(o[3]=__builtin_amdgcn_mfma_f32_32x32x16_bf16(PAF(0),VFS(1),o[3],0,0,0), C1,2); VRDS(1,6,vp2_); \
    GAPB2(o[2]=__builtin_amdgcn_mfma_f32_32x32x16_bf16(PAF(1),VFS(2),o[2],0,0,0), C1,4); VRDS(2,3,vp2_); \
    GAPB2(o[3]=__builtin_amdgcn_mfma_f32_32x32x16_bf16(PAF(1),VFS(3),o[3],0,0,0), C1,6); VRDS(3,7,vp2_); \
    GAPB2(o[2]=__builtin_amdgcn_mfma_f32_32x32x16_bf16(PAF(2),VFS(0),o[2],0,0,0), C1,8); \
    GAPB2(o[3]=__builtin_amdgcn_mfma_f32_32x32x16_bf16(PAF(2),VFS(1),o[3],0,0,0), C1,10); \
    GAPB2(o[2]=__builtin_amdgcn_mfma_f32_32x32x16_bf16(PAF(3),VFS(2),o[2],0,0,0), C1,12); \
    GAPB2(o[3]=__builtin_amdgcn_mfma_f32_32x32x16_bf16(PAF(3),VFS(3),o[3],0,0,0), C1,14); \
    } else { \
    GAPB(o[0]=__builtin_amdgcn_mfma_f32_32x32x16_bf16(PAF(0),VFR(0),o[0],0,0,0), C0,0); \
    GAPB(o[1]=__builtin_amdgcn_mfma_f32_32x32x16_bf16(PAF(0),VFR(4),o[1],0,0,0), C0,4); \
    KRD(GL,0); GAPB(o[0]=__builtin_amdgcn_mfma_f32_32x32x16_bf16(PAF(1),VFR(1),o[0],0,0,0), C0,8); \
    KRD(GL,1); GAPB(o[1]=__builtin_amdgcn_mfma_f32_32x32x16_bf16(PAF(1),VFR(5),o[1],0,0,0), C0,12); \
    KRD(GL,2); GAPB(o[0]=__builtin_amdgcn_mfma_f32_32x32x16_bf16(PAF(2),VFR(2),o[0],0,0,0), C1,0); \
    KRD(GL,3); GAPB(o[1]=__builtin_amdgcn_mfma_f32_32x32x16_bf16(PAF(2),VFR(6),o[1],0,0,0), C1,4); \
    GAPB(o[0]=__builtin_amdgcn_mfma_f32_32x32x16_bf16(PAF(3),VFR(3),o[0],0,0,0), C1,8); \
    GAPB(o[1]=__builtin_amdgcn_mfma_f32_32x32x16_bf16(PAF(3),VFR(7),o[1],0,0,0), C1,12); \
    } \
    }while(0)
  int t=1;
  #undef CMASK
  #define CMASK(P0,P1,t) do{}while(0)
  for(;t+5<NT;t+=2){
    STEP(pB0,pB1,pA0,pA1,t,true,true,true);     WAIT_STEP(); RESC(); ROT(); BLK(t+1);
    STEP(pA0,pA1,pB0,pB1,t+1,true,true,true);   WAIT_STEP(); RESC(); ROT();
  }
  #undef CMASK
  #define CMASK(P0,P1,t) do{int jb_=(t)-(NT-4); if(jb_>=0)cmask(P0,P1,jb_,qrel,hi);}while(0)
  #define ENDW(tt) do{ if constexpr(V128){ if((tt)+3<NT){WAIT_BAR(3);} else if((tt)+2<NT){WAIT_BAR(2);} else {WAIT_BAR(0);} } else { if((tt)+3<NT){WAIT_BAR(2);} else if((tt)+2<NT){WAIT_BAR(1);} else {WAIT_BAR(0);} } }while(0)
  for(;t+1<NT;t+=2){
    STEP(pB0,pB1,pA0,pA1,t,(t+3<NT),(t+1<NT),(t+1<NT));       ENDW(t);   RESC(); ROT(); BLK(t+1);
    STEP(pA0,pA1,pB0,pB1,t+1,(t+4<NT),(t+2<NT),(t+2<NT));     ENDW(t+1); RESC(); ROT();
  }
  STEP(pB0,pB1,pA0,pA1,NT-1,false,false,false); RESC();
  { float sacc=pB0[0]+pB0[1]; _Pragma("unroll") for(int r=2;r<16;++r)sacc+=pB0[r]; _Pragma("unroll") for(int r=0;r<16;++r)sacc+=pB1[r]; l_reg+=sacc;
    pw0=(u32x4){PKW(pB0,0),PKW(pB0,2),PKW(pB0,4),PKW(pB0,6)};pw1=(u32x4){PKW(pB0,8),PKW(pB0,10),PKW(pB0,12),PKW(pB0,14)};pw2=(u32x4){PKW(pB1,0),PKW(pB1,2),PKW(pB1,4),PKW(pB1,6)};pw3=(u32x4){PKW(pB1,8),PKW(pB1,10),PKW(pB1,12),PKW(pB1,14)};
    SBAR(); pv(o,vb0+sl_cur,PAF(0),PAF(1),PAF(2),PAF(3)); if constexpr(V128){ SBAR(); pv(o+2,vb0+sl_cur+(LDS_V2-LDS_V),PAF(0),PAF(1),PAF(2),PAF(3)); } }
  #undef PKW
  #undef PAF
  #undef VFR
  #undef PIN
  #undef MX3
  #undef GAPA
  #undef GAPB
  #undef GAPB2
  #undef CINIT
  #undef VRDS
  #undef VFS
  #undef EX
  #undef VRD
  #undef KRD
  #undef STEP
  #undef ENDW
  {auto rr=__builtin_amdgcn_permlane32_swap(__float_as_uint(l_reg),__float_as_uint(l_reg),false,false);l_reg=__uint_as_float(rr[0])+__uint_as_float(rr[1]);}
  if(hi==0)wsf[32+r32]=l_reg;asm volatile("s_waitcnt lgkmcnt(0)":::"memory");
  float rli[16];
  #pragma unroll
  for(int r=0;r<16;++r)rli[r]=__builtin_amdgcn_rcpf(wsf[32+crow(r,hi)]);
  bf16*Ow=Oh+(long)(q0+wid*QBLK)*DM; const bf16*Gw=MOBA?Gh+(long)(q0+wid*QBLK)*DM:nullptr;
  _Pragma("unroll") for(int hp=0;hp<(V128?2:1);++hp)
  { bf16*stg=(bf16*)(shm+LDS_OST)+wid*2048;
    #pragma unroll
    for(int r=0;r<16;++r){const int orow=crow(r,hi);
      #pragma unroll
      for(int d0=0;d0<2;++d0)stg[orow*64+d0*32+r32]=__float2bfloat16(o[2*hp+d0][r]*rli[r]);}
    asm volatile("s_waitcnt lgkmcnt(0)":::"memory");
    #pragma unroll
    for(int i=0;i<4;++i){const int row=i*8+(lane>>3),ch=lane&7; u32x4 v=*(const u32x4*)(stg+row*64+ch*8);
      if constexpr(MOBA){ const u32x4 gg=__builtin_nontemporal_load((const u32x4*)(Gw+(long)row*DM+ch*8));
        _Pragma("unroll") for(int k=0;k<4;++k){ const float lo=__uint_as_float(v[k]<<16)*__uint_as_float(gg[k]<<16), hi_=__uint_as_float(v[k]&0xffff0000u)*__uint_as_float(gg[k]&0xffff0000u); v[k]=cvtpk_s(lo,hi_);} }
      ATTN_STORE16(Ow+(long)row*DM+hp*64+ch*8,v);}
    asm volatile("s_waitcnt lgkmcnt(0)":::"memory"); }
  asm volatile("s_waitcnt lgkmcnt(0)\n\ts_barrier":::"memory");
  #undef DMA_K
  #undef DMA_V
  #undef WAIT_STEP
  #undef CMASK
  #undef START
  #undef RESC
  #undef ROT
  #undef MOBA_STAGE
  #undef MOBA_GATE
  #undef MOBA_T0
  #undef BLK
}
constexpr int ATTN_LDS_BYTES=LDS_BYTES;
#undef SBAR
#undef WAIT_BAR
}
constexpr int NWAVES = 8;
constexpr int BATCH = 2, T = 8192, D = 1024, M = BATCH * T, NIN = 6144, PLE = 256, DW = 512;
constexpr size_t MiB = 1u << 20;
constexpr size_t WS_CTL = 0, CTL_ZERO_BYTES = 1 * MiB, WS_KMEAN = 512 * 1024;
constexpr size_t WS_WIN = 2 * MiB, WS_WD = 14 * MiB, WS_WM = 15 * MiB, WS_WO = 16 * MiB, WS_WG = 18 * MiB, WS_WP = 20 * MiB, WS_ROPE = 21 * MiB, WS_PB = 22 * MiB;
constexpr size_t WS_XN = 32 * MiB;
constexpr size_t WS_DQ = 64 * MiB, WS_DK = 80 * MiB, WS_DV = 96 * MiB, WS_DG = 112 * MiB, WS_MQ = 128 * MiB, WS_MK = 144 * MiB, WS_MV = 160 * MiB, WS_MG = 176 * MiB;
constexpr size_t WS_GA = 192 * MiB, WS_GB = 224 * MiB, WS_END = 256 * MiB;
constexpr size_t WS_OA = WS_DQ;
constexpr size_t WS_MERGED = WS_DK;
constexpr size_t WS_X1B = WS_MK;
constexpr int CW_Q = 16320;
constexpr int CW_LOC = 12288;
constexpr int CW_BAR = 4096, CW_SEAM = 8192;
constexpr size_t WS_XBUF = 640 * 1024;
constexpr int RING_OFF = 0, RING_BYTES = 131072;
constexpr int LDSCTL_OFF = RING_BYTES, MISC_OFF = LDSCTL_OFF + 320;
constexpr int LDS_BYTES = 147456;

#define GAS __attribute__((address_space(1)))
#define LAS __attribute__((address_space(3)))
typedef unsigned short bf16;
typedef unsigned v4u __attribute__((ext_vector_type(4)));
typedef unsigned v2u __attribute__((ext_vector_type(2)));
typedef float f32x4 __attribute__((ext_vector_type(4)));
#define LDS_WAIT() asm volatile("s_waitcnt lgkmcnt(0)" ::: "memory")
#define VM_WAIT() asm volatile("s_waitcnt vmcnt(0)" ::: "memory")
__device__ __forceinline__ unsigned f2bf(float f) { unsigned u = __builtin_bit_cast(unsigned, f); return (u + 0x7fffu + ((u >> 16) & 1u)) >> 16; }
__device__ __forceinline__ unsigned pk2(float lo, float hi) { return f2bf(lo) | (f2bf(hi) << 16); }
__device__ __forceinline__ float blo(unsigned w) { return __uint_as_float(w << 16); }
__device__ __forceinline__ float bhi(unsigned w) { return __uint_as_float(w & 0xffff0000u); }

struct Frame {
    LAS unsigned char* lds;
    int tid, lane, wave, vcu, G;
};
struct Args { const float* in[15]; float* out; unsigned char* ws; };
typedef const __attribute__((address_space(4))) Args* KArgs;
__device__ __forceinline__ KArgs kargs_ptr() { KArgs a = (KArgs)__builtin_amdgcn_kernarg_segment_ptr(); asm volatile("" : "+s"(a)); return a; }
__device__ __forceinline__ Frame mk_frame(unsigned char* lds, int wv) {
    Frame F; F.lds = (LAS unsigned char*)lds;
    asm volatile("" : "+s"(wv));
    int tid = wv * 64 + lane_id_opaque(); asm volatile("" : "+v"(tid));
    int bx = blockIdx.x, G = gridDim.x; asm volatile("" : "+s"(bx), "+s"(G));
    F.tid = tid; F.lane = tid & 63; F.wave = wv;
    F.G = G; F.vcu = (G % 8 == 0) ? (bx % 8) * (G / 8) + bx / 8 : bx;
    return F;
}
__device__ __forceinline__ float wave_sum(float v) {
    v += swz_xor<1>(v); v += swz_xor<2>(v); v += swz_xor<4>(v); v += swz_xor<8>(v); v += swz_xor<16>(v);
    return half_sum(v);
}
__device__ __forceinline__ void p0_transpose_item(const float* W, int K, int N, bf16* WT, LAS float* scr, int item, int lane) {
    const int nblk = N / 32, kb = item / nblk, nb = item % nblk, k0 = 64 * kb, n0 = 32 * nb;
#pragma unroll 16
    for (int i = 0; i < 32; ++i) { const int kk = 2 * i + (lane >> 5); scr[kk * 33 + (lane & 31)] = __builtin_nontemporal_load(W + (size_t)(k0 + kk) * N + n0 + (lane & 31)); }
    LDS_WAIT(); asm volatile("" ::: "memory");
    const int c = lane & 7;
#pragma unroll
    for (int j = 0; j < 4; ++j) { const int n = (lane >> 3) + 8 * j; const LAS float* s = scr + (8 * c) * 33 + n;
        v4u o; o.x = pk2(s[0 * 33], s[1 * 33]); o.y = pk2(s[2 * 33], s[3 * 33]); o.z = pk2(s[4 * 33], s[5 * 33]); o.w = pk2(s[6 * 33], s[7 * 33]);
        *(GAS v4u*)(WT + (size_t)(n0 + n) * K + k0 + 8 * c) = o; }
    LDS_WAIT(); asm volatile("" ::: "memory");
}
__constant__ float ROPE_INV[8] = {1.0f, 0.1939227432012558f, 0.03760603070259094f, 0.007292664609849453f, 0.0014142135623842478f, 0.00027424818836152554f, 5.318296098266728e-05f, 1.0313386155758053e-05f};

__device__ __forceinline__ void p0_prologue(unsigned char* ldsp, int wv) {
    Frame F = mk_frame(ldsp, wv); KArgs ka = kargs_ptr();
    unsigned char* ws = ka->ws;
    LAS float* scr = (LAS float*)(F.lds + RING_OFF + F.wave * 16384);
    const int gw = F.vcu * NWAVES + F.wave, NGW = F.G * NWAVES;
    constexpr int I_IN = (D / 64) * (NIN / 32), I_D = (DW / 64) * (D / 32), I_O = (D / 64) * (D / 32), I_P = (PLE / 64) * (D / 32);
    (void)I_D; (void)I_O; (void)I_P;
    for (int it = gw; it < I_IN; it += NGW) p0_transpose_item(ka->in[3], D, NIN, (bf16*)(ws + WS_WIN), scr, it, F.lane);
    {
        const GAS f32x4* gp = (const GAS f32x4*)ka->in[2] + F.lane; f32x4 gv[4];
#pragma unroll
        for (int j = 0; j < 4; ++j) gv[j] = gp[64 * j];
        for (int m = gw; m < M; m += 2 * NGW) {
            const int m2 = m + NGW; const bool has2 = m2 < M; const int mb = has2 ? m2 : m;
            const GAS f32x4* xr = (const GAS f32x4*)(ka->in[0] + (size_t)m * D) + F.lane; const GAS f32x4* xr2 = (const GAS f32x4*)(ka->in[0] + (size_t)mb * D) + F.lane;
            f32x4 v[4], w[4]; float s = 0.f, s2 = 0.f;
#pragma unroll
            for (int j = 0; j < 4; ++j) { v[j] = __builtin_nontemporal_load(xr + 64 * j); w[j] = __builtin_nontemporal_load(xr2 + 64 * j); }
#pragma unroll
            for (int j = 0; j < 4; ++j) { s += (v[j].x * v[j].x + v[j].y * v[j].y) + (v[j].z * v[j].z + v[j].w * v[j].w); s2 += (w[j].x * w[j].x + w[j].y * w[j].y) + (w[j].z * w[j].z + w[j].w * w[j].w); }
            const float rstd = 1.f / sqrtf(wave_sum(s) * (1.f / D) + 1e-6f), rstd2 = 1.f / sqrtf(wave_sum(s2) * (1.f / D) + 1e-6f);
            GAS unsigned long long* o8 = (GAS unsigned long long*)(ws + WS_XN + (size_t)m * D * 2) + F.lane;
#pragma unroll
            for (int j = 0; j < 4; ++j) { const f32x4 y = v[j] * rstd * gv[j]; o8[64 * j] = (unsigned long long)pk2(y.x, y.y) | ((unsigned long long)pk2(y.z, y.w) << 32); }
            if (has2) { GAS unsigned long long* p8 = (GAS unsigned long long*)(ws + WS_XN + (size_t)m2 * D * 2) + F.lane;
#pragma unroll
                for (int j = 0; j < 4; ++j) { const f32x4 y = w[j] * rstd2 * gv[j]; p8[64 * j] = (unsigned long long)pk2(y.x, y.y) | ((unsigned long long)pk2(y.z, y.w) << 32); } }
        }
    }
    for (int idx = gw * 64 + F.lane; idx < T * 8; idx += NGW * 64) {
        const int pos = idx >> 3, j = idx & 7; const float ang = (float)pos * ROPE_INV[j];
        const double a = (double)ang; const double k = rint(a * 0.15915494309189535); const float r = (float)(a - k * 6.283185307179586);
        float* tp = (float*)(ws + WS_ROPE) + (size_t)pos * 16 + j; tp[0] = cosf(r); tp[8] = sinf(r);
    }
    for (int idx = gw * 64 + F.lane; idx < 2 * 8 * 32 * 64; idx += NGW * 64) ((float*)(ws + WS_KMEAN))[idx] = 0.f;
}

__device__ __forceinline__ void p2_pre(unsigned char* ldsp, int wv) {
    Frame F = mk_frame(ldsp, wv); KArgs ka = kargs_ptr();
    unsigned char* ws = ka->ws;
    LAS float* scr = (LAS float*)(F.lds + RING_OFF + F.wave * 16384);
    const int gw = F.vcu * NWAVES + F.wave, NGW = F.G * NWAVES;
    constexpr int I_D = (DW / 64) * (D / 32), I_O = (D / 64) * (D / 32), I_P = (PLE / 64) * (D / 32);
    constexpr int NITEMS = 2 * I_D + 2 * I_O + I_P;
    for (int it = gw; it < NITEMS; it += NGW) {
        int r = it;
        if (r < I_D) { p0_transpose_item(ka->in[9], DW, D, (bf16*)(ws + WS_WD), scr, r, F.lane); continue; } r -= I_D;
        if (r < I_D) { p0_transpose_item(ka->in[10], DW, D, (bf16*)(ws + WS_WM), scr, r, F.lane); continue; } r -= I_D;
        if (r < I_O) { p0_transpose_item(ka->in[11], D, D, (bf16*)(ws + WS_WO), scr, r, F.lane); continue; } r -= I_O;
        if (r < I_O) { p0_transpose_item(ka->in[13], D, D, (bf16*)(ws + WS_WG), scr, r, F.lane); continue; } r -= I_O;
        p0_transpose_item(ka->in[12], PLE, D, (bf16*)(ws + WS_WP), scr, r, F.lane);
    }
    for (int m = gw; m < M; m += NGW) {
        const f32x4 v = __builtin_nontemporal_load((const GAS f32x4*)(ka->in[1] + (size_t)m * PLE) + F.lane);
        *((GAS unsigned long long*)(ws + WS_PB + (size_t)m * PLE * 2) + F.lane) = (unsigned long long)pk2(v.x, v.y) | ((unsigned long long)pk2(v.z, v.w) << 32);
    }
    LDS_WAIT(); __syncthreads();
}
__device__ __forceinline__ void p2_attention(unsigned char* ldsg, int wv) {
    Frame F = mk_frame(ldsg, wv); unsigned char* ws = kargs_ptr()->ws;
    using abf = attn_body::bf16;
    volatile LAS unsigned* MI = (volatile LAS unsigned*)(F.lds + MISC_OFF);
    unsigned* qhead = (unsigned*)(ws + WS_CTL) + CW_Q;
    const int nP = (F.vcu < 256) ? (256 - F.vcu + F.G - 1) / F.G : 0;
    for (int task = 0; ; ++task) {
        int type, st, qb;
        if (task < 2 * nP) { const int P = F.vcu + (task >> 1) * F.G; type = task & 1; st = P >> 4; qb = 31 - (P & 15); }
        else {
            if (F.tid == 0) MI[14] = __hip_atomic_fetch_add(qhead, 1u, __ATOMIC_RELAXED, __HIP_MEMORY_SCOPE_AGENT);
            __syncthreads();
            const unsigned idx = MI[14];
            __syncthreads();
            if (idx >= 512u) break;
            type = (int)(idx >> 4) & 1; st = (int)idx & 15; qb = 15 - (int)(idx >> 5);
        }
        if (type == 0) { const int mm = st & 1, h = (st >> 1) & 3, b = st >> 3; const size_t rb = (size_t)b * T * DW;
            const abf* Q = (const abf*)(ws + WS_DQ) + rb + (2 * h + mm) * 64; const abf* K = (const abf*)(ws + WS_DK) + rb + (2 * h + mm) * 64;
            const abf* V = (const abf*)(ws + WS_DV) + rb + h * 128; abf* O = (abf*)(ws + WS_XN) + (size_t)mm * M * DW + rb + h * 128;
            attn_body::attn_unit<8, false, true>(qb, Q, K, V, O, nullptr, nullptr, (char*)ldsg, F.wave);
        } else { const int b = st >> 3, h = st & 7; const size_t rb = (size_t)b * T * DW + h * 64;
            abf* Q = (abf*)(ws + WS_MQ) + rb; const abf* K = (const abf*)(ws + WS_MK) + rb; const abf* V = (const abf*)(ws + WS_MV) + rb; const abf* Gt = (const abf*)(ws + WS_MG) + rb;
            const float* km = (const float*)(ws + WS_KMEAN) + (size_t)((b * 8 + h) * 32) * 64;
            attn_body::attn_unit<8, true, false>(qb, Q, K, V, Q, Gt, km, (char*)ldsg, F.wave);
        }
    }
}

__device__ __forceinline__ void p3_combine(unsigned char* ldsp, int wv) {
    Frame F = mk_frame(ldsp, wv); KArgs ka = kargs_ptr();
    unsigned char* ws = ka->ws;
    int gw = F.vcu * NWAVES + F.wave, NGW = F.G * NWAVES, rbase = 0, rend = M;
    { volatile LAS unsigned* MI = (volatile LAS unsigned*)(F.lds + MISC_OFF);
      if (MI[10]) { const int xl = (int)MI[11] >> 3, r = ((int)MI[11] & 7) + 8 * (int)MI[12]; rbase = 2048 * xl; rend = 2048; gw = r * NWAVES + F.wave; NGW = 32 * NWAVES; } }
    const float d1 = wave_sum(ka->in[4][F.lane] * ka->in[5][F.lane]), d2 = wave_sum(ka->in[6][F.lane] * ka->in[7][F.lane]);
    const float lam_init = 0.2f, lam = expf(d1) - expf(d2) + lam_init;
    const int e0 = (8 * F.lane) & 127; float sg[8];
#pragma unroll
    for (int i = 0; i < 8; ++i) sg[i] = ka->in[8][e0 + i] * (1.0f - lam_init);
    for (int m0 = gw; m0 < rend; m0 += 2 * NGW) {
        v4u a[2], b[2], g[2]; size_t off[2]; const bool has2 = (m0 + NGW) < rend;
#pragma unroll
        for (int q = 0; q < 2; ++q) { const int m = rbase + ((q && has2) ? m0 + NGW : m0); off[q] = (size_t)m * DW + 8 * F.lane;
            a[q] = __builtin_nontemporal_load((const GAS v4u*)((const bf16*)(ws + WS_XN) + off[q])); b[q] = __builtin_nontemporal_load((const GAS v4u*)((const bf16*)(ws + WS_XN) + (size_t)M * DW + off[q])); g[q] = __builtin_nontemporal_load((const GAS v4u*)((const bf16*)(ws + WS_DG) + off[q])); }
#pragma unroll
        for (int q = 0; q < 2; ++q) { if (q && !has2) break;
            float d[8]; float ss = 0.f;
#pragma unroll
            for (int k = 0; k < 4; ++k) { d[2 * k] = blo(a[q][k]) - lam * blo(b[q][k]); d[2 * k + 1] = bhi(a[q][k]) - lam * bhi(b[q][k]); ss += d[2 * k] * d[2 * k] + d[2 * k + 1] * d[2 * k + 1]; }
            ss += swz_xor<1>(ss); ss += swz_xor<2>(ss); ss += swz_xor<4>(ss); ss += swz_xor<8>(ss);
            const float rstd = 1.f / sqrtf(ss * (1.f / 128.f) + 1e-5f);
            v4u o;
#pragma unroll
            for (int k = 0; k < 4; ++k) o[k] = pk2(d[2 * k] * rstd * sg[2 * k] * blo(g[q][k]), d[2 * k + 1] * rstd * sg[2 * k + 1] * bhi(g[q][k]));
            *(GAS v4u*)((bf16*)(ws + WS_OA) + off[q]) = o; }
    }
}
__device__ __forceinline__ void p7_final(unsigned char* ldsp, int wv) {
    Frame F = mk_frame(ldsp, wv); KArgs ka = kargs_ptr();
    const int gw = F.vcu * NWAVES + F.wave, NGW = F.G * NWAVES;
    const GAS f32x4* gp = (const GAS f32x4*)ka->in[14] + F.lane; f32x4 gv[4];
#pragma unroll
    for (int j = 0; j < 4; ++j) gv[j] = gp[64 * j];
    for (int m = gw; m < M; m += NGW) {
        GAS f32x4* xr = (GAS f32x4*)(ka->out + (size_t)m * D) + F.lane; f32x4 v[4]; float s = 0.f;
#pragma unroll
        for (int j = 0; j < 4; ++j) { v[j] = xr[64 * j]; s += (v[j].x * v[j].x + v[j].y * v[j].y) + (v[j].z * v[j].z + v[j].w * v[j].w); }
        const float rstd = 1.f / sqrtf(wave_sum(s) * (1.f / D) + 1e-6f);
#pragma unroll
        for (int j = 0; j < 4; ++j) xr[64 * j] = v[j] * rstd * gv[j];
    }
}

__device__ __forceinline__ void p1_inproj(unsigned char* ldsp, int wv) {
    Frame F = mk_frame(ldsp, wv); unsigned char* ws = kargs_ptr()->ws;
    pg8::Gemm g{(const pg8::bf16_t*)(ws + WS_XN), (const pg8::bf16_t*)(ws + WS_WIN), nullptr, nullptr, M, NIN, D};
    pg8::StaticOrder S; S.init(M, NIN, F.G, (int)blockIdx.x);
    pg8::EpiInProj E{ws + WS_DQ, ws + WS_GA, (const float*)(ws + WS_ROPE), (float*)(ws + WS_KMEAN), attn_body::C2};
    pg8::gemm_phase<pg8::EpiInProj, pg8::StaticOrder, true, true>(F.lds + RING_OFF, g, S, E, F.wave);
}
__device__ __forceinline__ void p4a_ple(unsigned char* ldsp, int wv) {
    Frame F = mk_frame(ldsp, wv); unsigned char* ws = kargs_ptr()->ws;
    pg8::Gemm g{(const pg8::bf16_t*)(ws + WS_PB), (const pg8::bf16_t*)(ws + WS_WP), nullptr, nullptr, M, D, PLE};
    pg8::StaticOrder S; S.init(M, D, F.G, (int)blockIdx.x); { volatile LAS unsigned* MI = (volatile LAS unsigned*)(F.lds + MISC_OFF); if (MI[10]) S.fix((int)MI[11], (int)MI[12]); }
    const bool in_out = F.G == 256;
    pg8::EpiStore E{in_out ? (pg8::bf16_t*)kargs_ptr()->out : (pg8::bf16_t*)(ws + WS_XN), in_out ? 2 * D : D, in_out ? 512 : 256};
    pg8::gemm_phase<pg8::EpiStore, pg8::StaticOrder, true, true>(F.lds + RING_OFF, g, S, E, F.wave);
}
__device__ __forceinline__ void p4b_branches(unsigned char* ldsp, int wv) {
    Frame F = mk_frame(ldsp, wv); unsigned char* ws = kargs_ptr()->ws;
    pg8::Gemm g{(const pg8::bf16_t*)(ws + WS_OA), (const pg8::bf16_t*)(ws + WS_WD), (const pg8::bf16_t*)(ws + WS_MQ), (const pg8::bf16_t*)(ws + WS_WM), M, D, DW};
    pg8::PairOrder S; S.init(M, D, F.G, (int)blockIdx.x); { volatile LAS unsigned* MI = (volatile LAS unsigned*)(F.lds + MISC_OFF); if (MI[10]) S.s.fix((int)MI[11], (int)MI[12]); }
    pg8::EpiMerge E{(const pg8::bf16_t*)(ws + WS_GA), (const pg8::bf16_t*)(ws + WS_GB), (pg8::bf16_t*)(ws + WS_MERGED)};
    pg8::gemm_phase<pg8::EpiMerge, pg8::PairOrder, true, true>(F.lds + RING_OFF, g, S, E, F.wave);
}
__device__ __forceinline__ void p5_out(unsigned char* ldsp, int wv) {
    Frame F = mk_frame(ldsp, wv); KArgs ka = kargs_ptr(); unsigned char* ws = ka->ws;
    pg8::Gemm g{(const pg8::bf16_t*)(ws + WS_MERGED), (const pg8::bf16_t*)(ws + WS_WO), nullptr, nullptr, M, D, D};
    pg8::StaticOrder S; S.init(M, D, F.G, (int)blockIdx.x); { volatile LAS unsigned* MI = (volatile LAS unsigned*)(F.lds + MISC_OFF); if (MI[10]) S.fix((int)MI[11], (int)MI[12]); }
    if (F.G == 256) {
        pg8::EpiResid<false> E{ka->in[0], ka->out, (pg8::bf16_t*)(ws + WS_X1B)};
        pg8::gemm_phase<pg8::EpiResid<false>, pg8::StaticOrder, true, true>(F.lds + RING_OFF, g, S, E, F.wave);
    } else {
        pg8::EpiResid<true> E{ka->in[0], ka->out, (pg8::bf16_t*)(ws + WS_X1B)};
        pg8::gemm_phase<pg8::EpiResid<true>, pg8::StaticOrder, true, true>(F.lds + RING_OFF, g, S, E, F.wave);
    }
}
__device__ __forceinline__ void p6_ple(unsigned char* ldsp, int wv) {
    Frame F = mk_frame(ldsp, wv); KArgs ka = kargs_ptr(); unsigned char* ws = ka->ws;
    pg8::Gemm g{(const pg8::bf16_t*)(ws + WS_X1B), (const pg8::bf16_t*)(ws + WS_WG), nullptr, nullptr, M, D, D};
    pg8::StaticOrder S; S.init(M, D, F.G, (int)blockIdx.x); { volatile LAS unsigned* MI = (volatile LAS unsigned*)(F.lds + MISC_OFF); if (MI[10]) S.fix((int)MI[11], (int)MI[12]); }
    if (F.G == 256) {
        pg8::EpiPleNorm E{ka->out, (const pg8::bf16_t*)(ws + WS_X1B), (const pg8::bf16_t*)ka->out, ka->in[14], (float*)(ws + WS_XBUF), (unsigned*)(ws + WS_CTL) + CW_SEAM};
        pg8::gemm_phase<pg8::EpiPleNorm, pg8::StaticOrder, false, true>(F.lds + RING_OFF, g, S, E, F.wave);
    } else {
        pg8::EpiPle E{ka->out, (const pg8::bf16_t*)(ws + WS_XN)};
        pg8::gemm_phase<pg8::EpiPle, pg8::StaticOrder, true, true>(F.lds + RING_OFF, g, S, E, F.wave);
    }
}

#define XB_TMO      128
#define XB_XCNT(j)  (256  + 64 * (j))
#define XB_XSUB(j)  (1280 + 64 * (j))
#define XB_XGEN(j)  (2304 + 64 * (j))
#define XB_TOP      3328
#define XB_TOPGEN   3392
#define XCD_BAR_WORDS 3456
#define XB_SPIN_CAP (1u << 18)

__device__ __forceinline__ unsigned xb_ld(unsigned* p)              { return __hip_atomic_load(p, __ATOMIC_RELAXED, __HIP_MEMORY_SCOPE_AGENT); }
__device__ __forceinline__ unsigned xb_add(unsigned* p, unsigned v) { return __hip_atomic_fetch_add(p, v, __ATOMIC_RELAXED, __HIP_MEMORY_SCOPE_AGENT); }
__device__ __forceinline__ unsigned xb_xcc_id() { return (unsigned)__builtin_amdgcn_s_getreg((3 << 11) | 20) & 0xFu; }
#define XB_SPIN(cond, bar) do { unsigned _sp = 0; while (cond) { __builtin_amdgcn_s_sleep(1); \
    if ((++_sp & 255u) == 0u) { if (xb_ld(&(bar)[XB_TMO])) break; if (_sp > XB_SPIN_CAP) { atomicAdd(&(bar)[XB_TMO], 1u); break; } } } } while (0)

struct XcdBarrier {
    unsigned* bar; unsigned x;
    volatile LAS unsigned* st;
};

__device__ __forceinline__ XcdBarrier xcd_barrier_post(unsigned* bar, volatile LAS unsigned* st) {
    XcdBarrier b; b.bar = bar; b.x = xb_xcc_id(); b.st = st;
    if (threadIdx.x == 0) (void)xb_add(&bar[XB_XCNT(b.x)], 1u);
    return b;
}
__device__ __forceinline__ void xcd_barrier_complete(unsigned* bar, unsigned x, unsigned& nloc, unsigned& nx) {
    const unsigned G = gridDim.x * gridDim.y * gridDim.z;
    unsigned sum, cnt, mine, sp = 0u;
    for (;;) {
        sum = 0u; cnt = 0u; mine = 0u;
#pragma unroll
        for (unsigned j = 0; j < 16; ++j) { const unsigned c = xb_ld(&bar[XB_XCNT(j)]); sum += c; cnt += (c > 0u) ? 1u : 0u; mine = (j == x) ? c : mine; }
        if (sum == G) break;
        __builtin_amdgcn_s_sleep(1);
        if ((++sp & 255u) == 0u) { if (xb_ld(&bar[XB_TMO])) break; if (sp > XB_SPIN_CAP) { atomicAdd(&bar[XB_TMO], 1u); break; } }
    }
    nloc = mine > 0u ? mine : 1u; nx = cnt > 0u ? cnt : 1u;
}

__device__ __forceinline__ void xcd_barrier(const XcdBarrier& b) {
    asm volatile("s_waitcnt vmcnt(0)" ::: "memory");
    __syncthreads();
    if (threadIdx.x == 0) {
        unsigned* bar = b.bar;
        __builtin_amdgcn_s_waitcnt(0);
        unsigned nloc = b.st[0], nx = b.st[1];
        if (nloc == 0u) { xcd_barrier_complete(bar, b.x, nloc, nx); b.st[0] = nloc; b.st[1] = nx; }
        const unsigned old = xb_add(&bar[XB_XSUB(b.x)], 1u);
        const unsigned gen = old / nloc;
        if (old + 1u == (gen + 1u) * nloc) {
            __builtin_amdgcn_fence(__ATOMIC_RELEASE, "agent");
            asm volatile("s_waitcnt vmcnt(0)" ::: "memory");
            const unsigned og = xb_add(&bar[XB_TOP], 1u);
            const unsigned tg = og / nx;
            if (og + 1u == (tg + 1u) * nx) xb_add(&bar[XB_TOPGEN], 1u);
            else XB_SPIN(xb_ld(&bar[XB_TOPGEN]) == tg, bar);
            __builtin_amdgcn_fence(__ATOMIC_ACQUIRE, "agent");
            xb_add(&bar[XB_XGEN(b.x)], 1u);
            asm volatile("s_waitcnt vmcnt(0)" ::: "memory");
        } else {
            XB_SPIN(xb_ld(&bar[XB_XGEN(b.x)]) == gen, bar);
            __builtin_amdgcn_fence(__ATOMIC_ACQUIRE, "agent");
            asm volatile("s_waitcnt vmcnt(0)" ::: "memory");
        }
    }
    __syncthreads();
}
__device__ __forceinline__ void grid_bar(unsigned char* ldsp) {
    XcdBarrier b; b.bar = (unsigned*)(kargs_ptr()->ws + WS_CTL) + CW_BAR; b.x = xb_xcc_id(); b.st = (volatile LAS unsigned*)((LAS unsigned char*)ldsp + MISC_OFF) + 8;
    xcd_barrier(b);
}
__device__ __forceinline__ void xcc_bar(unsigned char* ldsp) {
    asm volatile("s_waitcnt vmcnt(0)" ::: "memory");
    __syncthreads();
    if (threadIdx.x == 0) {
        unsigned* ctl = (unsigned*)(kargs_ptr()->ws + WS_CTL); const unsigned x = xb_xcc_id();
        __builtin_amdgcn_s_waitcnt(0);
        const unsigned old = xb_add(&ctl[CW_LOC + 64 * x], 1u), gen = old / 32u;
        if (old + 1u == (gen + 1u) * 32u) xb_add(&ctl[CW_LOC + 1024 + 64 * x], 1u);
        else { unsigned sp = 0; while (xb_ld(&ctl[CW_LOC + 1024 + 64 * x]) == gen) { __builtin_amdgcn_s_sleep(1); if (++sp > (1u << 22)) break; } }
        __builtin_amdgcn_fence(__ATOMIC_ACQUIRE, "agent");
        asm volatile("s_waitcnt vmcnt(0)" ::: "memory");
    }
    __syncthreads();
}
__device__ __forceinline__ void xcc_mode_setup(unsigned char* ldsp) {
    volatile LAS unsigned* MI = (volatile LAS unsigned*)((LAS unsigned char*)ldsp + MISC_OFF);
    if (threadIdx.x == 0) {
        unsigned* bar = (unsigned*)(kargs_ptr()->ws + WS_CTL) + CW_BAR; const unsigned x = xb_xcc_id();
        unsigned npop = 0, xl = 0; bool ok = true;
#pragma unroll
        for (unsigned j = 0; j < 16; ++j) { const unsigned c = xb_ld(&bar[XB_XCNT(j)]); if (c) { ++npop; ok = ok && (c == 32u); if (j < x) ++xl; } }
        const unsigned r = MI[13]; ok = ok && npop == 8u && gridDim.x == 256u && r < 32u;
        MI[10] = ok ? 1u : 0u; MI[11] = 8u * xl + (r & 7u); MI[12] = r >> 3;
    }
    __syncthreads();
}
__global__ void __launch_bounds__(NWAVES * 64, 2) fwd_mega(Args args_unused) {
    extern __shared__ __attribute__((aligned(16))) unsigned char lds[];
    const int wv = __builtin_amdgcn_readfirstlane((int)threadIdx.x >> 6);
    for (int u = threadIdx.x; u < (LDS_BYTES - LDSCTL_OFF) / 4; u += NWAVES * 64) ((LAS unsigned*)((LAS unsigned char*)lds + LDSCTL_OFF))[u] = 0u;
    if (blockIdx.x == 0) { GAS v4u* z = (GAS v4u*)(kargs_ptr()->ws + WS_CTL); for (int u = threadIdx.x; u < 65536 / 16; u += NWAVES * 64) z[u] = (v4u){0u, 0u, 0u, 0u}; }
    asm volatile("s_waitcnt vmcnt(0)" ::: "memory");
    __syncthreads();
    cg::this_grid().sync();
    if (threadIdx.x == 0) { unsigned* bar_ = (unsigned*)(kargs_ptr()->ws + WS_CTL) + CW_BAR; ((volatile LAS unsigned*)((LAS unsigned char*)lds + MISC_OFF))[13] = xb_add(&bar_[XB_XCNT(xb_xcc_id())], 1u); }
#define GRID_BAR() grid_bar(lds)
    p0_prologue(lds, wv);      GRID_BAR();  xcc_mode_setup(lds);
    p1_inproj(lds, wv);        GRID_BAR();
    p2_pre(lds, wv); p2_attention(lds, wv);     GRID_BAR();
    p3_combine(lds, wv);       if (((volatile LAS unsigned*)((LAS unsigned char*)lds + MISC_OFF))[10] != 0u) xcc_bar(lds); else GRID_BAR();
    p4a_ple(lds, wv);
    const bool xmode = ((volatile LAS unsigned*)((LAS unsigned char*)lds + MISC_OFF))[10] != 0u;
    p4b_branches(lds, wv);     if (xmode) xcc_bar(lds); else GRID_BAR();
    p5_out(lds, wv);           if (xmode) xcc_bar(lds); else GRID_BAR();
    p6_ple(lds, wv);
    if (gridDim.x != 256) { GRID_BAR(); p7_final(lds, wv); }
}

extern "C" void kernel_launch(void* const* d_in, const int* in_sizes, int n_in, void* d_out, int out_size, void* d_ws, size_t ws_size, hipStream_t stream) {
    static int grid = 0;
    if (grid == 0) {
        if (n_in != 15 || in_sizes[0] != M * D || out_size != M * D || ws_size < WS_END) { fprintf(stderr, "kernel_launch: unexpected shapes (n_in %d, in0 %d, out %d, ws %zu)\n", n_in, n_in > 0 ? in_sizes[0] : -1, out_size, ws_size); grid = -1; return; }
        int dev = 0, cus = 0, per_cu = 0;
        if (hipGetDevice(&dev) != hipSuccess || hipDeviceGetAttribute(&cus, hipDeviceAttributeMultiprocessorCount, dev) != hipSuccess) { grid = -1; return; }
        if (hipFuncSetAttribute((const void*)fwd_mega, hipFuncAttributeMaxDynamicSharedMemorySize, LDS_BYTES) != hipSuccess) { fprintf(stderr, "kernel_launch: hipFuncSetAttribute failed\n"); grid = -1; return; }
        if (hipOccupancyMaxActiveBlocksPerMultiprocessor(&per_cu, (const void*)fwd_mega, NWAVES * 64, LDS_BYTES) != hipSuccess || per_cu < 1) { fprintf(stderr, "kernel_launch: occupancy query says %d\n", per_cu); per_cu = 1; }
        (void)hipGetLastError();
        grid = cus * per_cu;
    }
    if (grid < 0) return;
    Args a{};
    for (int i = 0; i < 15; ++i) a.in[i] = (const float*)d_in[i];
    a.out = (float*)d_out; a.ws = (unsigned char*)d_ws;
    void* kargs[] = {&a};
    hipError_t e = hipLaunchCooperativeKernel((const void*)fwd_mega, dim3(grid), dim3(NWAVES * 64), kargs, LDS_BYTES, stream);
    if (e != hipSuccess) fprintf(stderr, "cooperative launch failed: %s (grid %d)\n", hipGetErrorString(e), grid);
}
```

```cpp
#include <hip/hip_runtime.h>
#include <hip/hip_cooperative_groups.h>
#include <cstdio>
#include <cstdint>
namespace cg = cooperative_groups;
template <int K> __device__ __forceinline__ float swz_xor(float v) { return __int_as_float(__builtin_amdgcn_ds_swizzle(__float_as_int(v), 0x1f | (K << 10))); }
__device__ __forceinline__ float half_sum(float v) { auto rr = __builtin_amdgcn_permlane32_swap(__float_as_uint(v), __float_as_uint(v), false, false); return __uint_as_float(rr[0]) + __uint_as_float(rr[1]); }
__device__ __forceinline__ int lane_id_opaque() { unsigned m = ~0u; asm volatile("" : "+s"(m)); return (int)__builtin_amdgcn_mbcnt_hi(m, __builtin_amdgcn_mbcnt_lo(m, 0u)); }
namespace pg8 {
#define PG8_LAS __attribute__((address_space(3)))
typedef unsigned short bf16_t;
typedef short bf16x8 __attribute__((ext_vector_type(8)));
typedef float f32x4 __attribute__((ext_vector_type(4)));
typedef unsigned u32x4 __attribute__((ext_vector_type(4)));
constexpr int BM = 256, BK = 64, HALF = 128, HTB = HALF * BK * 2  , STAGE_BYTES = 8 * HTB, NXCD = 8, WGM = 8;

__host__ __device__ __forceinline__ int lds_byte(int r, int c) { const int st = (r >> 4) * 2 + (c >> 5), rr = r & 15, cc = c & 31, ob = rr * 64 + cc * 2; return st * 1024 + (ob ^ (((ob >> 9) & 1) << 5)); }
__host__ __device__ __forceinline__ void stage_rc(int b, int& R, int& C) { const int st = b / 1024, sb = b % 1024, swz = sb ^ (((sb >> 9) & 1) << 5); R = (st >> 1) * 16 + swz / 64; C = (st & 1) * 32 + (swz % 64) / 2; }
__host__ __device__ __forceinline__ int perm32(int rho) { const int n = rho >> 4, i = rho & 15; return 8 * (i >> 2) + 4 * n + (i & 3); }

struct Unit { int pm, pn, g; };
struct Gemm { const bf16_t* A0; const bf16_t* B0t; const bf16_t* A1; const bf16_t* B1t; int M, N, K; };

struct StaticOrder {
    int nM, nN, nwg, G, c, fx, fpm, fpn;
    __host__ __device__ void init(int M, int N, int G_, int c_) { nM = M / BM; nN = N / BM; nwg = nM * nN; G = G_; c = c_; fx = 0; fpm = 0; fpn = 0; }
    __host__ __device__ void fix(int pm, int pn) { fx = 1; fpm = pm; fpn = pn; }
    __host__ __device__ bool next(int i, Unit& u) const {
        if (fx) { if (i >= 1) return false; u.pm = fpm; u.pn = fpn; u.g = 0; return true; }
        const long L = (long)i * G + c; if (L >= nwg) return false;
        int wgid = (int)L; { const int q = nwg / NXCD, r = nwg % NXCD, xcd = wgid % NXCD, off = wgid / NXCD; wgid = (xcd < r ? xcd * (q + 1) : r * (q + 1) + (xcd - r) * q) + off; }
        const int nig = WGM * nN, gid = wgid / nig, fm = gid * WGM, gsz = (nM - fm) < WGM ? (nM - fm) : WGM;
        u.pm = fm + ((wgid % nig) % gsz); u.pn = (wgid % nig) / gsz; u.g = 0; return true;
    }
    __device__ __forceinline__ void a_ready(const Unit&) const {}
    __device__ __forceinline__ void done(const Unit&) const {}
};

__device__ __forceinline__ unsigned cvt_pk_bf16(float lo, float hi) { unsigned r; asm volatile("v_cvt_pk_bf16_f32 %0, %1, %2" : "=v"(r) : "v"(lo), "v"(hi)); return r; }
__device__ __forceinline__ float bf_lo(unsigned w) { return __uint_as_float(w << 16); }
__device__ __forceinline__ float bf_hi(unsigned w) { return __uint_as_float(w & 0xffff0000u); }
__device__ __forceinline__ float sigmoid_f(float v) { return __builtin_amdgcn_rcpf(1.0f + __expf(-v)); }
__device__ __forceinline__ f32x4 sigmoid4(f32x4 v) { return (f32x4){sigmoid_f(v[0]), sigmoid_f(v[1]), sigmoid_f(v[2]), sigmoid_f(v[3])}; }
typedef unsigned u32x2 __attribute__((ext_vector_type(2)));

struct EpiInProj {
    static constexpr bool PERM = true, AFTER_DRAIN = false, CHAIN = false;
    unsigned char* seg0;
    unsigned char* gseg0;
    const float* rope;
    float* kmean;
    float qscale;
    __device__ __forceinline__ void operator()(f32x4 (&acc)[2][2][4][2], const Unit& u, int wr, int wc, int fr, int fq) const {
        const int pn = u.pn; bf16_t* base; int ldc, colt, mode; float sc = 1.f;
        if (pn < 16) { const int seg = pn >> 1; base = (bf16_t*)(seg0 + (size_t)seg * (16u << 20)); ldc = 512; colt = (pn & 1) * 256;
            mode = (seg == 0 || seg == 1 || seg == 4 || seg == 5) ? 1 : ((seg == 3 || seg == 7) ? 2 : 0); if (seg == 0 || seg == 4) sc = qscale; }
        else { base = (bf16_t*)(gseg0 + (size_t)((pn - 16) >> 2) * (32u << 20)); ldc = 1024; colt = ((pn - 16) & 3) * 256; mode = 3; }
        const int row0 = u.pm * BM + wr * 64 + fr, col0 = colt + wc * 32 + 8 * fq;
        if (mode == 1 && (wc & 1) == 0) {
            const float sgn = (fq == 0) ? -1.f : ((fq == 1) ? 1.f : 0.f); const bool rot = fq < 2;
#pragma unroll
            for (int ai = 0; ai < 2; ++ai)
#pragma unroll
                for (int m = 0; m < 4; ++m) { const int t = (row0 + ai * HALF + m * 16) & 8191; const f32x4* tp = (const f32x4*)(rope + (size_t)t * 16);
                    f32x4 cs[2], sn[2]; cs[0] = tp[0]; cs[1] = tp[1]; sn[0] = tp[2]; sn[1] = tp[3];
#pragma unroll
                    for (int bj = 0; bj < 2; ++bj)
#pragma unroll
                        for (int n = 0; n < 2; ++n) { f32x4 v = acc[ai][bj][m][n], p;
                            p[0] = swz_xor<16>(v[0]); p[1] = swz_xor<16>(v[1]); p[2] = swz_xor<16>(v[2]); p[3] = swz_xor<16>(v[3]);
                            const f32x4 o = v * cs[n] + (p * sn[n]) * sgn; acc[ai][bj][m][n] = rot ? o : v; } }
        }
        if (pn == 10 || pn == 11) {
            const int b = u.pm >> 5, nblk = u.pm & 31;
#pragma unroll
            for (int bj = 0; bj < 2; ++bj)
#pragma unroll
                for (int n = 0; n < 2; ++n) { f32x4 s = (f32x4){0.f, 0.f, 0.f, 0.f};
#pragma unroll
                    for (int ai = 0; ai < 2; ++ai)
#pragma unroll
                        for (int m = 0; m < 4; ++m) s += acc[ai][bj][m][n];
#pragma unroll
                    for (int j = 0; j < 4; ++j) { float x = s[j]; x += swz_xor<1>(x); x += swz_xor<2>(x); x += swz_xor<4>(x); x += swz_xor<8>(x);
                        if (fr == 0) { const int cg_ = (pn - 10) * 256 + bj * HALF + wc * 32 + 8 * fq + 4 * n + j; atomicAdd(kmean + ((size_t)((b * 8 + (cg_ >> 6)) * 32 + nblk)) * 64 + (cg_ & 63), x * (1.0f / 256.0f)); } } }
        }
#pragma unroll
        for (int ai = 0; ai < 2; ++ai)
#pragma unroll
            for (int m = 0; m < 4; ++m) { bf16_t* rowp = base + (size_t)(row0 + ai * HALF + m * 16) * ldc + col0;
#pragma unroll
                for (int bj = 0; bj < 2; ++bj) { f32x4 v0 = acc[ai][bj][m][0], v1 = acc[ai][bj][m][1];
                    if (mode == 2) { v0 = v0 * sigmoid4(v0); v1 = v1 * sigmoid4(v1); }
                    else if (mode == 3) { v0 = sigmoid4(v0); v1 = sigmoid4(v1); }
                    v0 = v0 * sc; v1 = v1 * sc; u32x4 w; w.x = cvt_pk_bf16(v0[0], v0[1]); w.y = cvt_pk_bf16(v0[2], v0[3]); w.z = cvt_pk_bf16(v1[0], v1[1]); w.w = cvt_pk_bf16(v1[2], v1[3]);
                    if (mode >= 2) __builtin_nontemporal_store(w, (u32x4*)(rowp + bj * HALF)); else *(u32x4*)(rowp + bj * HALF) = w; } }
    }
};
struct EpiStore {
    static constexpr bool PERM = true, AFTER_DRAIN = false, CHAIN = false;
    bf16_t* O; int ldc; int tstride;
    __device__ __forceinline__ void operator()(f32x4 (&acc)[2][2][4][2], const Unit& u, int wr, int wc, int fr, int fq) const {
        const int row0 = u.pm * BM + wr * 64 + fr, col0 = u.pn * tstride + wc * 32 + 8 * fq;
#pragma unroll
        for (int ai = 0; ai < 2; ++ai)
#pragma unroll
            for (int m = 0; m < 4; ++m) { bf16_t* rowp = O + (size_t)(row0 + ai * HALF + m * 16) * ldc + col0;
#pragma unroll
                for (int bj = 0; bj < 2; ++bj) { const f32x4 v0 = acc[ai][bj][m][0], v1 = acc[ai][bj][m][1];
                    u32x4 w; w.x = cvt_pk_bf16(v0[0], v0[1]); w.y = cvt_pk_bf16(v0[2], v0[3]); w.z = cvt_pk_bf16(v1[0], v1[1]); w.w = cvt_pk_bf16(v1[2], v1[3]);
                    *(u32x4*)(rowp + bj * HALF) = w; } }
    }
};
struct EpiMerge {
    static constexpr bool PERM = true, AFTER_DRAIN = false, CHAIN = true;
    const bf16_t* SA; const bf16_t* SB; bf16_t* O;
    __device__ __forceinline__ void operator()(f32x4 (&acc)[2][2][4][2], const Unit& u, int wr, int wc, int fr, int fq) const {
        const int row0 = u.pm * BM + wr * 64 + fr, col0 = u.pn * BM + wc * 32 + 8 * fq;
#pragma unroll
        for (int ai = 0; ai < 2; ++ai)
#pragma unroll
            for (int m = 0; m < 4; ++m) { const size_t off = (size_t)(row0 + ai * HALF + m * 16) * 1024 + col0;
#pragma unroll
                for (int bj = 0; bj < 2; ++bj) { const u32x4 b = *(const u32x4*)(SB + off + bj * HALF);
                    const f32x4 b0 = (f32x4){bf_lo(b.x), bf_hi(b.x), bf_lo(b.y), bf_hi(b.y)}, b1 = (f32x4){bf_lo(b.z), bf_hi(b.z), bf_lo(b.w), bf_hi(b.w)};
                    if (u.g == 0) { const u32x4 a = *(const u32x4*)(SA + off + bj * HALF);
                        const f32x4 a0 = (f32x4){bf_lo(a.x), bf_hi(a.x), bf_lo(a.y), bf_hi(a.y)}, a1 = (f32x4){bf_lo(a.z), bf_hi(a.z), bf_lo(a.w), bf_hi(a.w)};
                        f32x4 r0, r1;
#pragma unroll
                        for (int j = 0; j < 4; ++j) { r0[j] = a0[j] * __builtin_amdgcn_rcpf(b0[j]); r1[j] = a1[j] * __builtin_amdgcn_rcpf(b1[j]); }
                        acc[ai][bj][m][0] *= r0; acc[ai][bj][m][1] *= r1; }
                    else { const f32x4 v0 = acc[ai][bj][m][0] * b0, v1 = acc[ai][bj][m][1] * b1;
                        u32x4 w; w.x = cvt_pk_bf16(v0[0], v0[1]); w.y = cvt_pk_bf16(v0[2], v0[3]); w.z = cvt_pk_bf16(v1[0], v1[1]); w.w = cvt_pk_bf16(v1[2], v1[3]);
                        *(u32x4*)(O + off + bj * HALF) = w; } }
                asm volatile("" ::: "memory"); }
    }
};
template <bool WRITE_F32> struct EpiResid {
    static constexpr bool PERM = false, AFTER_DRAIN = false, CHAIN = false;
    const float* X; float* out; bf16_t* xb;
    __device__ __forceinline__ void operator()(f32x4 (&acc)[2][2][4][2], const Unit& u, int wr, int wc, int fr, int fq) const {
        const int col0 = u.pn * BM + wc * 32 + 4 * fq;
#pragma unroll
        for (int ai = 0; ai < 2; ++ai)
#pragma unroll
            for (int m = 0; m < 4; ++m) { const size_t off = (size_t)(u.pm * BM + ai * HALF + wr * 64 + m * 16 + fr) * 1024 + col0;
#pragma unroll
                for (int bj = 0; bj < 2; ++bj)
#pragma unroll
                    for (int n = 0; n < 2; ++n) { const size_t o2 = off + bj * HALF + n * 16; const f32x4 v = __builtin_nontemporal_load((const f32x4*)(X + o2)) + acc[ai][bj][m][n];
                        if (WRITE_F32) *(f32x4*)(out + o2) = v; u32x2 w; w.x = cvt_pk_bf16(v[0], v[1]); w.y = cvt_pk_bf16(v[2], v[3]); *(u32x2*)(xb + o2) = w; } }
    }
};
struct EpiPle {
    static constexpr bool PERM = false, AFTER_DRAIN = false, CHAIN = false;
    float* out; const bf16_t* ple;
    __device__ __forceinline__ void operator()(f32x4 (&acc)[2][2][4][2], const Unit& u, int wr, int wc, int fr, int fq) const {
        const int col0 = u.pn * BM + wc * 32 + 4 * fq;
#pragma unroll
        for (int ai = 0; ai < 2; ++ai)
#pragma unroll
            for (int m = 0; m < 4; ++m) { const size_t off = (size_t)(u.pm * BM + ai * HALF + wr * 64 + m * 16 + fr) * 1024 + col0;
#pragma unroll
                for (int bj = 0; bj < 2; ++bj)
#pragma unroll
                    for (int n = 0; n < 2; ++n) { const size_t o2 = off + bj * HALF + n * 16; const u32x2 pw = __builtin_nontemporal_load((const u32x2*)(ple + o2));
                        const f32x4 pl = (f32x4){bf_lo(pw.x), bf_hi(pw.x), bf_lo(pw.y), bf_hi(pw.y)};
                        const f32x4 v = *(const f32x4*)(out + o2) + sigmoid4(acc[ai][bj][m][n]) * pl; *(f32x4*)(out + o2) = v; } }
    }
};
struct EpiPleNorm {
    static constexpr bool PERM = false, AFTER_DRAIN = true, CHAIN = false;
    float* out; const bf16_t* x1b; const bf16_t* ple; const float* fg; float* xbuf; unsigned* cnt;
    __device__ __forceinline__ void operator()(f32x4 (&acc)[2][2][4][2], const Unit& u, int wr, int wc, int fr, int fq) const {}
    __device__ __forceinline__ void fused(f32x4 (&acc)[2][2][4][2], const Unit& u, int wr, int wc, int fr, int fq, PG8_LAS unsigned char* lds, int wid, int lane) const {
        PG8_LAS float* P = (PG8_LAS float*)lds;
        PG8_LAS float* S = (PG8_LAS float*)(lds + 4096);
        const int col0 = u.pn * BM + wc * 32 + 4 * fq;
#pragma unroll
        for (int ai = 0; ai < 2; ++ai)
#pragma unroll
            for (int m = 0; m < 4; ++m) { const size_t off = (size_t)(u.pm * BM + ai * HALF + wr * 64 + m * 16 + fr) * 1024 + col0;
#pragma unroll
                for (int bj = 0; bj < 2; ++bj)
#pragma unroll
                    for (int n = 0; n < 2; ++n) { const size_t o2 = off + bj * HALF + n * 16; const u32x2 pw = __builtin_nontemporal_load((const u32x2*)(ple + o2 + (off - col0) + u.pn * BM));
                        const f32x4 pl = (f32x4){bf_lo(pw.x), bf_hi(pw.x), bf_lo(pw.y), bf_hi(pw.y)};
                        const u32x2 xw = *(const u32x2*)(x1b + o2); const f32x4 x1 = (f32x4){bf_lo(xw.x), bf_hi(xw.x), bf_lo(xw.y), bf_hi(xw.y)};
                        acc[ai][bj][m][n] = x1 + sigmoid4(acc[ai][bj][m][n]) * pl; }
                asm volatile("" : "+v"(acc[ai][0][m][0]), "+v"(acc[ai][0][m][1]), "+v"(acc[ai][1][m][0]), "+v"(acc[ai][1][m][1]));
                if (m & 1) asm volatile("" ::: "memory"); }
#pragma unroll
        for (int ai = 0; ai < 2; ++ai)
#pragma unroll
            for (int m = 0; m < 4; ++m) { float s = 0.f;
#pragma unroll
                for (int bj = 0; bj < 2; ++bj)
#pragma unroll
                    for (int n = 0; n < 2; ++n) { const f32x4 x = acc[ai][bj][m][n]; s += (x[0] * x[0] + x[1] * x[1]) + (x[2] * x[2] + x[3] * x[3]); }
                s += swz_xor<16>(s); s = half_sum(s);
                if (fq == 0) P[(ai * HALF + wr * 64 + m * 16 + fr) * 4 + wc] = s; }
        asm volatile("s_waitcnt lgkmcnt(0)" ::: "memory"); __builtin_amdgcn_s_barrier(); asm volatile("" ::: "memory");
        const int row = wid * 32 + (lane & 31);
        if (lane < 32) { const float t = (P[row * 4 + 0] + P[row * 4 + 1]) + (P[row * 4 + 2] + P[row * 4 + 3]);
            __hip_atomic_store(xbuf + (size_t)(u.pm * BM + row) * 4 + u.pn, t, __ATOMIC_RELAXED, __HIP_MEMORY_SCOPE_AGENT); }
        asm volatile("s_waitcnt vmcnt(0)" ::: "memory");
        if (lane == 0) __hip_atomic_fetch_add(cnt + 64 * u.pm, 1u, __ATOMIC_RELAXED, __HIP_MEMORY_SCOPE_AGENT);
        if (wid == 0) { unsigned sp = 0;
            while ((unsigned)__builtin_amdgcn_readfirstlane(__hip_atomic_load(cnt + 64 * u.pm, __ATOMIC_RELAXED, __HIP_MEMORY_SCOPE_AGENT)) < 32u) { __builtin_amdgcn_s_sleep(2); if (++sp > (1u << 22)) break; }
            __builtin_amdgcn_fence(__ATOMIC_ACQUIRE, "agent"); }
        asm volatile("s_waitcnt vmcnt(0) lgkmcnt(0)" ::: "memory"); __builtin_amdgcn_s_barrier(); asm volatile("" ::: "memory");
        if (lane < 32) { const float* slot = xbuf + (size_t)(u.pm * BM + row) * 4; float q = 0.f;
#pragma unroll
            for (int t = 0; t < 4; ++t) q += __hip_atomic_load(slot + t, __ATOMIC_RELAXED, __HIP_MEMORY_SCOPE_AGENT);
            S[row] = 1.0f / sqrtf(q * (1.0f / 1024.0f) + 1e-6f); }
        asm volatile("s_waitcnt lgkmcnt(0)" ::: "memory"); __builtin_amdgcn_s_barrier(); asm volatile("" ::: "memory");
        f32x4 gv[2][2];
#pragma unroll
        for (int bj = 0; bj < 2; ++bj)
#pragma unroll
            for (int n = 0; n < 2; ++n) gv[bj][n] = *(const f32x4*)(fg + col0 + bj * HALF + n * 16);
#pragma unroll
        for (int ai = 0; ai < 2; ++ai)
#pragma unroll
            for (int m = 0; m < 4; ++m) { const int r = ai * HALF + wr * 64 + m * 16 + fr; const float rs = S[r]; const size_t off = (size_t)(u.pm * BM + r) * 1024 + col0;
#pragma unroll
                for (int bj = 0; bj < 2; ++bj)
#pragma unroll
                    for (int n = 0; n < 2; ++n) __builtin_nontemporal_store(acc[ai][bj][m][n] * rs * gv[bj][n], (f32x4*)(out + off + bj * HALF + n * 16)); }
    }
};
struct PairOrder {
    StaticOrder s;
    __host__ __device__ void init(int M, int N, int G_, int c_) { s.init(M, N, G_, c_); }
    __host__ __device__ bool next(int i, Unit& u) const { if (!s.next(i >> 1, u)) return false; u.g = i & 1; return true; }
    __device__ __forceinline__ void a_ready(const Unit&) const {}
    __device__ __forceinline__ void done(const Unit&) const {}
};
template <class Epi, class Sched, bool ALIGN_EPI = false, bool SP2 = false>
__device__ __forceinline__ void gemm_phase(PG8_LAS unsigned char* lds, const Gemm g, const Sched& S, const Epi& E, int wv_) {
    int tid_ = wv_ * 64 + lane_id_opaque(); asm volatile("" : "+v"(tid_));
    const int tid = tid_, wid = __builtin_amdgcn_readfirstlane(tid >> 6), lane = tid & 63, wr = wid >> 2, wc = wid & 3, fr = lane & 15, fq = lane >> 4;
    const int K = g.K, nt = K / BK;
    unsigned voffA[2], voffB[2];
#pragma unroll
    for (int i = 0; i < 2; ++i) { int R, C; stage_rc(tid * 16 + i * 8192, R, C); const int Rb = Epi::PERM ? ((R & ~31) + perm32(R & 31)) : R;
        voffA[i] = (unsigned)(R * K + C) * 2u; voffB[i] = (unsigned)(Rb * K + C) * 2u; }
    const size_t kstep = (size_t)(BK * 2);
    const size_t hstep = (size_t)HALF * K * 2;
    const size_t tstep = 2 * hstep;
    const unsigned ldsw = (unsigned)wid * 1024u;
    const int aoff = lds_byte(wr * 64 + fr, fq * 8), boff = lds_byte(wc * 32 + fr, fq * 8);
#define PG8_SA(b, h) (((b) * 2 + (h)) * HTB)
#define PG8_SB(b, h) ((4 + (b) * 2 + (h)) * HTB)
#define PG8_STAGE(bufoff, gbase, voff) do { _Pragma("unroll") for (int _i = 0; _i < 2; ++_i) \
        __builtin_amdgcn_global_load_lds((const unsigned*)((const char*)(gbase) + (voff)[_i]), (PG8_LAS unsigned*)(lds + (bufoff) + ldsw + _i * 8192), 16, 0, 0); } while (0)
#define PG8_LDA(dst, b, h) do { _Pragma("unroll") for (int m = 0; m < 4; ++m) _Pragma("unroll") for (int k = 0; k < 2; ++k) dst[m][k] = *(const PG8_LAS bf16x8*)(lds + PG8_SA(b, h) + aoff + m * 2048 + k * 1024); } while (0)
#define PG8_LDB(dst, b, h) do { _Pragma("unroll") for (int n = 0; n < 2; ++n) _Pragma("unroll") for (int k = 0; k < 2; ++k) dst[n][k] = *(const PG8_LAS bf16x8*)(lds + PG8_SB(b, h) + boff + n * 2048 + k * 1024); } while (0)
#define PG8_MMA(ai, bj, At, Bt) do { __builtin_amdgcn_s_setprio(1); _Pragma("unroll") for (int m = 0; m < 4; ++m) _Pragma("unroll") for (int n = 0; n < 2; ++n) _Pragma("unroll") for (int k = 0; k < 2; ++k) \
        acc[ai][bj][m][n] = __builtin_amdgcn_mfma_f32_16x16x32_bf16(Bt[n][k], At[m][k], acc[ai][bj][m][n], 0, 0, 0); __builtin_amdgcn_s_setprio(0); } while (0)
#define PG8_WAIT_V(n) asm volatile("s_waitcnt vmcnt(" #n ")" ::: "memory")
#define PG8_WAIT_L(n) asm volatile("s_waitcnt lgkmcnt(" #n ")" ::: "memory")
#define PG8_BAR __builtin_amdgcn_s_barrier()
#define PG8_SCHED __builtin_amdgcn_sched_barrier(0)
    Unit cur, nxt; int ui = 0;
    if (!S.next(0, cur)) return;
    f32x4 acc[2][2][4][2];
#pragma unroll
    for (int a = 0; a < 2; ++a)
#pragma unroll
        for (int b = 0; b < 2; ++b)
#pragma unroll
            for (int m = 0; m < 4; ++m)
#pragma unroll
                for (int n = 0; n < 2; ++n) acc[a][b][m][n] = (f32x4){0.f, 0.f, 0.f, 0.f};
    bf16x8 At[4][2], B0[2][2], B1[2][2];
    const char* cA = (const char*)(cur.g ? g.A1 : g.A0) + (size_t)cur.pm * tstep; const char* cB = (const char*)(cur.g ? g.B1t : g.B0t) + (size_t)cur.pn * tstep;
    S.a_ready(cur);
    if constexpr (SP2) {
        PG8_STAGE(PG8_SB(0, 0), cB, voffB); PG8_STAGE(PG8_SB(0, 1), cB + hstep, voffB); PG8_STAGE(PG8_SA(0, 0), cA, voffA); PG8_STAGE(PG8_SA(0, 1), cA + hstep, voffA);
        if (wr == 1) PG8_BAR;
        PG8_WAIT_V(2); PG8_BAR;
        PG8_STAGE(PG8_SB(1, 0), cB + kstep, voffB); PG8_STAGE(PG8_SA(1, 0), cA + kstep, voffA); PG8_STAGE(PG8_SB(1, 1), cB + hstep + kstep, voffB);
        PG8_WAIT_V(6); PG8_BAR;
    } else {
        PG8_STAGE(PG8_SB(0, 0), cB, voffB); PG8_STAGE(PG8_SA(0, 0), cA, voffA); PG8_STAGE(PG8_SB(0, 1), cB + hstep, voffB); PG8_STAGE(PG8_SA(0, 1), cA + hstep, voffA);
        if (wr == 1) PG8_BAR;
        PG8_WAIT_V(4); PG8_BAR;
        PG8_STAGE(PG8_SB(1, 0), cB + kstep, voffB); PG8_STAGE(PG8_SA(1, 0), cA + kstep, voffA); PG8_STAGE(PG8_SB(1, 1), cB + hstep + kstep, voffB);
        PG8_WAIT_V(6); PG8_BAR;
    }
    for (;;) {
        const bool has_next = S.next(ui + 1, nxt);
        const char* nA = has_next ? (const char*)(nxt.g ? g.A1 : g.A0) + (size_t)nxt.pm * tstep : cA; const char* nB = has_next ? (const char*)(nxt.g ? g.B1t : g.B0t) + (size_t)nxt.pn * tstep : cB;
        for (int t = 0; t < nt; t += 2) {
            const bool last = (t == nt - 2);
            const char* a1 = cA + (size_t)(t + 1) * kstep;
            const char* a2 = last ? nA : cA + (size_t)(t + 2) * kstep; const char* b2 = last ? nB : cB + (size_t)(t + 2) * kstep;
            const char* a3 = a2 + kstep; const char* b3 = b2 + kstep;
            if (last && has_next) S.a_ready(nxt);
            if constexpr (SP2) {
            PG8_LDB(B0, 0, 0); PG8_LDB(B1, 0, 1); PG8_SCHED; PG8_LDA(At, 0, 0); PG8_STAGE(PG8_SA(1, 1), a1 + hstep, voffA);
            PG8_WAIT_V(8); PG8_WAIT_L(0); PG8_BAR; PG8_MMA(0, 0, At, B0); PG8_MMA(0, 1, At, B1); PG8_BAR; PG8_SCHED;
            PG8_LDA(At, 0, 1); PG8_STAGE(PG8_SB(0, 0), b2, voffB); PG8_STAGE(PG8_SB(0, 1), b2 + hstep, voffB); PG8_STAGE(PG8_SA(0, 0), a2, voffA);
            PG8_WAIT_V(8); PG8_WAIT_L(0); PG8_BAR; PG8_MMA(1, 0, At, B0); PG8_MMA(1, 1, At, B1); PG8_BAR; PG8_SCHED;
            PG8_LDB(B0, 1, 0); PG8_LDB(B1, 1, 1); PG8_SCHED; PG8_LDA(At, 1, 0); PG8_STAGE(PG8_SA(0, 1), a2 + hstep, voffA);
            PG8_WAIT_V(8); PG8_WAIT_L(0); PG8_BAR; PG8_MMA(0, 0, At, B0); PG8_MMA(0, 1, At, B1); PG8_BAR; PG8_SCHED;
            PG8_LDA(At, 1, 1); PG8_STAGE(PG8_SB(1, 0), b3, voffB); PG8_STAGE(PG8_SB(1, 1), b3 + hstep, voffB); PG8_STAGE(PG8_SA(1, 0), a3, voffA);
            PG8_WAIT_V(8); PG8_WAIT_L(0); PG8_BAR; PG8_MMA(1, 0, At, B0); PG8_MMA(1, 1, At, B1); PG8_BAR; PG8_SCHED;
            } else {
            PG8_LDB(B0, 0, 0); PG8_SCHED; PG8_LDA(At, 0, 0); PG8_STAGE(PG8_SA(1, 1), a1 + hstep, voffA);
            PG8_WAIT_L(8); PG8_BAR; PG8_WAIT_L(0); PG8_MMA(0, 0, At, B0); PG8_BAR; PG8_SCHED;
            PG8_LDB(B1, 0, 1); PG8_STAGE(PG8_SB(0, 0), b2, voffB);
            PG8_BAR; PG8_WAIT_L(0); PG8_MMA(0, 1, At, B1); PG8_BAR;
            PG8_LDA(At, 0, 1); PG8_STAGE(PG8_SA(0, 0), a2, voffA);
            PG8_BAR; PG8_WAIT_L(0); PG8_MMA(1, 0, At, B0); PG8_BAR; PG8_SCHED;
            PG8_STAGE(PG8_SB(0, 1), b2 + hstep, voffB);
            PG8_WAIT_V(6); PG8_BAR; PG8_MMA(1, 1, At, B1); PG8_BAR;
            PG8_LDB(B0, 1, 0); PG8_SCHED; PG8_LDA(At, 1, 0); PG8_STAGE(PG8_SA(0, 1), a2 + hstep, voffA);
            PG8_WAIT_L(8); PG8_BAR; PG8_WAIT_L(0); PG8_MMA(0, 0, At, B0); PG8_BAR; PG8_SCHED;
            PG8_LDB(B1, 1, 1); PG8_STAGE(PG8_SB(1, 0), b3, voffB);
            PG8_BAR; PG8_WAIT_L(0); PG8_MMA(0, 1, At, B1); PG8_BAR;
            PG8_LDA(At, 1, 1); PG8_STAGE(PG8_SA(1, 0), a3, voffA);
            PG8_BAR; PG8_WAIT_L(0); PG8_MMA(1, 0, At, B0); PG8_BAR; PG8_SCHED;
            PG8_STAGE(PG8_SB(1, 1), b3 + hstep, voffB);
            PG8_WAIT_V(6); PG8_BAR; PG8_MMA(1, 1, At, B1); PG8_BAR;
            }
        }
        if constexpr (ALIGN_EPI) { if (wr == 0) PG8_BAR; }
        if constexpr (!Epi::AFTER_DRAIN) { E(acc, cur, wr, wc, fr, fq); S.done(cur); }
        if (!has_next) break;
        if (!(Epi::CHAIN && cur.g == 0)) {
#pragma unroll
        for (int a = 0; a < 2; ++a)
#pragma unroll
            for (int b = 0; b < 2; ++b)
#pragma unroll
                for (int m = 0; m < 4; ++m)
#pragma unroll
                    for (int n = 0; n < 2; ++n) acc[a][b][m][n] = (f32x4){0.f, 0.f, 0.f, 0.f};
        }
        cur = nxt; cA = nA; cB = nB; ++ui;
        if constexpr (ALIGN_EPI) { if (wr == 1) PG8_BAR; }
    }
    PG8_WAIT_V(0);
    if constexpr (!ALIGN_EPI) { if (wr == 0) PG8_BAR; }
    PG8_BAR;
    if constexpr (Epi::AFTER_DRAIN) { E.fused(acc, cur, wr, wc, fr, fq, lds, wid, lane); S.done(cur); }
#undef PG8_SA
#undef PG8_SB
#undef PG8_STAGE
#undef PG8_LDA
#undef PG8_LDB
#undef PG8_MMA
#undef PG8_WAIT_V
#undef PG8_WAIT_L
#undef PG8_BAR
#undef PG8_SCHED
}
}
#include <hip/hip_bf16.h>
#include <cmath>
namespace attn_body {
using bf16=__hip_bfloat16;
using bf16x8=__attribute__((ext_vector_type(8)))short;
using s16x4=__attribute__((ext_vector_type(4)))short;
using f32x16=__attribute__((ext_vector_type(16)))float;
using u32x4=__attribute__((ext_vector_type(4)))unsigned;
using f32x4_t=__attribute__((ext_vector_type(4)))float;
constexpr int BATCH=2,SEQ=8192,D=64,DM=512;
constexpr int NW=8,QBLK=32,QB=QBLK*NW,KVBLK=64,NQB=SEQ/QB;
constexpr int ATTN_PITCH=DM, ATTN_UNIT_ROWS=QB;
__device__ __forceinline__ int crow(int r,int hi){return (r&3)+8*(r>>2)+4*hi;}
#define SBAR() __builtin_amdgcn_sched_barrier(0)
__device__ __forceinline__ void cmask(f32x16&p0,f32x16&p1,int jb,int qrel,int hi){
  const float NEG=-INFINITY; int kb=64*jb+4*hi;
  #pragma unroll
  for(int r=0;r<16;++r){int kv=kb+(r&3)+8*(r>>2); if(kv>qrel)p0[r]=NEG; if(kv+32>qrel)p1[r]=NEG;}
}

constexpr int NSLOT=3, SLOTB=8192;
constexpr int LDS_K=0, LDS_V=NSLOT*SLOTB, LDS_V2=2*NSLOT*SLOTB, LDS_WS=3*NSLOT*SLOTB, LDS_OST=LDS_WS+NW*64*4, LDS_BYTES=LDS_OST+NW*4096;
constexpr float C2=0.125f*1.4426950408889634f;
__device__ __forceinline__ void glds16(const void*gsrc,unsigned lds_dst){unsigned keep;
  asm volatile("s_mov_b32 %0, m0\n\ts_mov_b32 m0, %2\n\ts_nop 0\n\tglobal_load_lds_dwordx4 %1, off\n\ts_mov_b32 m0, %0":"=&s"(keep):"v"(gsrc),"s"(lds_dst):"memory");}
__device__ __forceinline__ float max3f(float a,float b,float c){float r;asm("v_max3_f32 %0, %1, %2, %3":"=v"(r):"v"(a),"v"(b),"v"(c));return r;}
__device__ __forceinline__ float max2f(float a,float b){float r;asm("v_max_f32_e32 %0, %1, %2":"=v"(r):"v"(a),"v"(b));return r;}
__device__ __forceinline__ float fadd_s(float a,float b){float r;asm("v_add_f32_e32 %0, %1, %2":"=v"(r):"v"(a),"v"(b));return r;}
__device__ __forceinline__ float fsub_s(float a,float b){float r;asm("v_sub_f32_e32 %0, %1, %2":"=v"(r):"v"(a),"v"(b));return r;}
typedef float f32x2_t __attribute__((ext_vector_type(2))); typedef __bf16 bf16x2_t __attribute__((ext_vector_type(2)));
__device__ __forceinline__ unsigned cvtpk_s(float lo,float hi){f32x2_t v={lo,hi};bf16x2_t b=__builtin_convertvector(v,bf16x2_t);return __builtin_bit_cast(unsigned,b);}
#define WAIT_BAR(N) asm volatile("s_waitcnt vmcnt(" #N ") lgkmcnt(0)\n\ts_barrier":::"memory")

__device__ __forceinline__ void qkt(f32x16&p0,f32x16&p1,const char*Kslot,const bf16x8*qr,const f32x16&negm,int r32,int hi){
  const char*kb=Kslot+hi*1024+r32*16;
  #pragma unroll
  for(int d0=0;d0<4;++d0){
    const bf16x8 b0=*reinterpret_cast<const bf16x8*>(kb+d0*2048);
    const bf16x8 b1=*reinterpret_cast<const bf16x8*>(kb+d0*2048+512);
    if(d0==0){p0=__builtin_amdgcn_mfma_f32_32x32x16_bf16(b0,qr[0],negm,0,0,0);p1=__builtin_amdgcn_mfma_f32_32x32x16_bf16(b1,qr[0],negm,0,0,0);}
    else{p0=__builtin_amdgcn_mfma_f32_32x32x16_bf16(b0,qr[d0],p0,0,0,0);p1=__builtin_amdgcn_mfma_f32_32x32x16_bf16(b1,qr[d0],p1,0,0,0);}}
}
typedef __attribute__((address_space(3))) const char* lds_cptr;
typedef short v4i16_t __attribute__((ext_vector_type(4)));
__device__ __forceinline__ void kload8(bf16x8*kf,lds_cptr kp){
  kf[0]=*(const __attribute__((address_space(3))) bf16x8*)(kp);      kf[1]=*(const __attribute__((address_space(3))) bf16x8*)(kp+512);
  kf[2]=*(const __attribute__((address_space(3))) bf16x8*)(kp+2048); kf[3]=*(const __attribute__((address_space(3))) bf16x8*)(kp+2560);
  kf[4]=*(const __attribute__((address_space(3))) bf16x8*)(kp+4096); kf[5]=*(const __attribute__((address_space(3))) bf16x8*)(kp+4608);
  kf[6]=*(const __attribute__((address_space(3))) bf16x8*)(kp+6144); kf[7]=*(const __attribute__((address_space(3))) bf16x8*)(kp+6656);
}
__device__ __forceinline__ void kload2(bf16x8*kf,lds_cptr kp,int j){ kf[2*j]=*(const __attribute__((address_space(3))) bf16x8*)(kp+j*2048); kf[2*j+1]=*(const __attribute__((address_space(3))) bf16x8*)(kp+j*2048+512); }
__device__ __forceinline__ s16x4 vtr(lds_cptr p){ return __builtin_bit_cast(s16x4,__builtin_amdgcn_ds_read_tr16_b64_v4i16((__attribute__((address_space(3))) v4i16_t*)p)); }
__device__ __forceinline__ float rowmax(const f32x16&p0,const f32x16&p1){
  float a=max3f(p0[0],p0[1],p1[0]),b=max3f(p0[2],p0[3],p1[1]);a=max3f(a,p1[2],p1[3]);
  #pragma unroll
  for(int r=4;r<16;r+=4){a=max3f(a,p0[r],p0[r+1]);b=max3f(b,p0[r+2],p0[r+3]);a=max3f(a,p1[r],p1[r+1]);b=max3f(b,p1[r+2],p1[r+3]);}
  const float m=max2f(a,b);
  auto rr=__builtin_amdgcn_permlane32_swap(__float_as_uint(m),__float_as_uint(m),false,false);
  return max2f(__uint_as_float(rr[0]),__uint_as_float(rr[1]));
}
__device__ __forceinline__ void pv(f32x16*o,int vb,bf16x8 pa0,bf16x8 pa1,bf16x8 pa2,bf16x8 pa3){
  #pragma unroll
  for(int d0=0;d0<2;++d0){s16x4 lo[4],hi[4];
    #pragma unroll
    for(int ks=0;ks<4;++ks){
      asm volatile("ds_read_b64_tr_b16 %0,%1 offset:%c2":"=&v"(lo[ks]):"v"(vb),"i"(d0*4096+ks*1024):"memory");
      asm volatile("ds_read_b64_tr_b16 %0,%1 offset:%c2":"=&v"(hi[ks]):"v"(vb),"i"(d0*4096+ks*1024+512):"memory");}
    asm volatile("s_waitcnt lgkmcnt(0)":::"memory");SBAR();
    #define PK(k) (bf16x8){lo[k][0],lo[k][1],lo[k][2],lo[k][3],hi[k][0],hi[k][1],hi[k][2],hi[k][3]}
    o[d0]=__builtin_amdgcn_mfma_f32_32x32x16_bf16(pa0,PK(0),o[d0],0,0,0);
    o[d0]=__builtin_amdgcn_mfma_f32_32x32x16_bf16(pa1,PK(1),o[d0],0,0,0);
    o[d0]=__builtin_amdgcn_mfma_f32_32x32x16_bf16(pa2,PK(2),o[d0],0,0,0);
    o[d0]=__builtin_amdgcn_mfma_f32_32x32x16_bf16(pa3,PK(3),o[d0],0,0,0);
    #undef PK
  }
}

#ifndef ATTN_STORE16
#define ATTN_STORE16(p,v) (*(u32x4*)(p)=(v))
#endif
template<int THRL,bool MOBA,bool V128> __device__ __forceinline__ void attn_unit(int qb,const bf16*Qh,const bf16*Kh,const bf16*Vh,bf16*Oh,const bf16*Gh,const float*km,char*shm,int wv_){
  int tid_=wv_*64+lane_id_opaque(); asm volatile("":"+v"(tid_)); const int tid=tid_,lane=tid&63,r32=lane&31,hi=lane>>5; const int wid=__builtin_amdgcn_readfirstlane(tid>>6);
  const int q0=qb*QB;
  const bf16*Qw=Qh+(long)(q0+wid*QBLK)*DM;
  const unsigned lds0=(unsigned)(uintptr_t)shm;
  float*wsf=(float*)(shm+LDS_WS)+wid*64;
  const bf16*ksrc=Kh+(long)lane*DM+wid*8;
  const bf16*vsrc=Vh+(long)(16*(wid&3)+(lane>>2))*DM+(wid>>2)*32+(lane&3)*8;
  const unsigned kdst=lds0+LDS_K+wid*1024, vdst=lds0+LDS_V+wid*1024;
  #define DMA_K(t,slot) glds16(ksrc+(long)(t)*KVBLK*DM,(unsigned)__builtin_amdgcn_readfirstlane(kdst+(slot)))
  #define DMA_V(t,slot) do{ glds16(vsrc+(long)(t)*KVBLK*DM,(unsigned)__builtin_amdgcn_readfirstlane(vdst+(slot))); if constexpr(V128) glds16(vsrc+64+(long)(t)*KVBLK*DM,(unsigned)__builtin_amdgcn_readfirstlane(vdst+(LDS_V2-LDS_V)+(slot))); }while(0)
  #define WAIT_STEP() do{ if constexpr(V128){WAIT_BAR(3);} else {WAIT_BAR(2);} }while(0)
  const int vb0=(int)(lds0+LDS_V)+((lane>>4)&1)*32+(lane&3)*8+(4*hi+((lane&15)>>2))*64;
  const char*Kbase=shm+LDS_K; bf16x8 kf[8];
  const lds_cptr shm3=(lds_cptr)shm; const lds_cptr kp0=shm3+LDS_K+hi*1024+r32*16; const lds_cptr vp0=shm3+LDS_V+((lane>>4)&1)*32+(lane&3)*8+(4*hi+((lane&15)>>2))*64;
  unsigned selm=0u; bool active=true;
  #define MOBA_STAGE() do{ if constexpr(MOBA){ if(tid<qb*16){ const f32x4_t kv_=((const f32x4_t*)km)[tid]; *(__attribute__((address_space(3))) f32x4_t*)(shm3+LDS_OST+tid*16)=kv_; } } }while(0)
  #define MOBA_GATE() do{ if constexpr(MOBA){ \
      float qf[32]; \
      _Pragma("unroll") for(int d0=0;d0<4;++d0) _Pragma("unroll") for(int i=0;i<8;++i) qf[d0*8+i]=__uint_as_float(((unsigned)(unsigned short)qr[d0][i])<<16); \
      float v1=-INFINITY,v2=-INFINITY,v3=-INFINITY; unsigned m1=0u,m2=0u,m3=0u; \
      const __attribute__((address_space(3))) f32x4_t* kml=(const __attribute__((address_space(3))) f32x4_t*)(shm3+LDS_OST)+hi*2; \
      for(int n=0;n<qb;++n){ float g=0.f; \
        _Pragma("unroll") for(int d0=0;d0<4;++d0){ const f32x4_t a_=kml[n*16+d0*4], b_=kml[n*16+d0*4+1]; \
          g+=qf[d0*8+0]*a_.x; g+=qf[d0*8+1]*a_.y; g+=qf[d0*8+2]*a_.z; g+=qf[d0*8+3]*a_.w; g+=qf[d0*8+4]*b_.x; g+=qf[d0*8+5]*b_.y; g+=qf[d0*8+6]*b_.z; g+=qf[d0*8+7]*b_.w; } \
        g=half_sum(g); const unsigned bit=1u<<n; \
        if(g>v1){v3=v2;m3=m2;v2=v1;m2=m1;v1=g;m1=bit;} else if(g>v2){v3=v2;m3=m2;v2=g;m2=bit;} else if(g>v3){v3=g;m3=bit;} } \
      selm=m1|m2|m3|(1u<<qb); active=(selm&1u)!=0u; } }while(0)
  #define MOBA_T0(P0,P1) do{ if constexpr(MOBA){ if(!active){ _Pragma("unroll") for(int r=0;r<16;++r){P0[r]=0.f;P1[r]=0.f;} } } }while(0)
  #define BLK(tt) do{ if constexpr(MOBA){ if((((tt))&3)==0){ active=((selm>>((tt)>>2))&1u)!=0u; const float nv_=active?-mhat:-INFINITY; _Pragma("unroll") for(int r=0;r<16;++r)negm[r]=nv_; asm volatile("":"+v"(negm)); } } }while(0)
  const int NT=(q0+QB)/KVBLK;
  DMA_K(0,0);DMA_V(0,0);DMA_K(1,SLOTB);
  bf16x8 qr[4];
  #pragma unroll
  for(int d0=0;d0<4;++d0)qr[d0]=*reinterpret_cast<const bf16x8*>(&Qw[(long)r32*DM+d0*16+hi*8]);
  float mhat=0.f,l_reg=0.f;f32x16 o[V128?4:2]; _Pragma("unroll") for(int i_=0;i_<(V128?4:2);++i_)o[i_]=f32x16{};f32x16 negm=f32x16{}; if constexpr(true){ float z_=0.f; asm volatile("":"+v"(z_)); _Pragma("unroll") for(int r=0;r<16;++r)negm[r]=z_; asm volatile("":"+v"(negm)); }
  const int qrel=wid*QBLK+r32;
  #define CMASK(P0,P1,t) do{int jb_=(t)-(NT-4); if(jb_>=0)cmask(P0,P1,jb_,qrel,hi);}while(0)
  bool resc=false;
  #define START(P0,P1) do{ const float rm=rowmax(P0,P1); resc=false; \
    { const float dl=rm; mhat=fadd_s(mhat,dl); \
      _Pragma("unroll") for(int r=0;r<16;++r){P0[r]=fsub_s(P0[r],dl);P1[r]=fsub_s(P1[r],dl);} \
      if constexpr(true){ { const float nv_=(MOBA&&!active)?-INFINITY:-mhat; _Pragma("unroll") for(int r=0;r<16;++r)negm[r]=nv_; } asm volatile("":"+v"(negm)); } } \
    _Pragma("unroll") for(int r=0;r<16;++r)P0[r]=__builtin_amdgcn_exp2f(P0[r]); }while(0)
  #define RESC() do{ if(resc){ asm volatile("s_waitcnt lgkmcnt(0)":::"memory"); \
      _Pragma("unroll") for(int d_=0;d_<(V128?4:2);++d_) _Pragma("unroll") for(int r=0;r<16;++r)o[d_][r]*=wsf[crow(r,hi)]; } }while(0)
  f32x16 pA0,pA1,pB0,pB1;
  int sl_prev=0,sl_cur=0,sl_next=SLOTB;
  #define ROT() do{sl_prev=sl_cur;sl_cur=sl_next;sl_next=(sl_next==(NSLOT-1)*SLOTB)?0:sl_next+SLOTB;}while(0)
  DMA_K(2,2*SLOTB);
  MOBA_STAGE();
  WAIT_BAR(3);
  MOBA_GATE();
  qkt(pA0,pA1,Kbase,qr,negm,r32,hi);asm volatile("s_nop 15\n\ts_nop 7":"+v"(pA0),"+v"(pA1));CMASK(pA0,pA1,0);
  START(pA0,pA1);
  _Pragma("unroll") for(int r=0;r<16;++r)pA1[r]=__builtin_amdgcn_exp2f(pA1[r]);
  MOBA_T0(pA0,pA1);
  WAIT_BAR(0);
  DMA_K(3,0);DMA_V(1,SLOTB);
  ROT();
  kload8(kf,kp0+sl_cur);
  WAIT_STEP();
  s16x4 vlo[8],vhi[8]; u32x4 pw0,pw1,pw2,pw3;
  #define PKW(P,B) cvtpk_s(P[B],P[B+1])
  #define PAF(k) __builtin_bit_cast(bf16x8,pw##k)
  #define VFR(i) (bf16x8){vlo[i][0],vlo[i][1],vlo[i][2],vlo[i][3],vhi[i][0],vhi[i][1],vhi[i][2],vhi[i][3]}
  #define PIN(x) asm volatile("":"+v"(x))
  #define MX3(a,b,c) __builtin_fmaxf(__builtin_fmaxf((a),(b)),(c))
  #define GAPA(MF,A0,A1,A2,A3,W0,W1,PW) do{ MF; sacc+=A0; sacc+=A1; sacc+=A2; sacc+=A3; PIN(sacc); W0; W1; PIN(PW); SBAR(); }while(0)
  #define EX(v) __builtin_amdgcn_exp2f(v)
  #define GAPB(MF,X,B) do{ MF; X[B]=EX(X[B]); X[B+1]=EX(X[B+1]); X[B+2]=EX(X[B+2]); X[B+3]=EX(X[B+3]); PIN(X); SBAR(); }while(0)
  #define CINIT negm
  #define GAPB2(MF,X,B) do{ MF; X[B]=EX(X[B]); X[B+1]=EX(X[B+1]); PIN(X); SBAR(); }while(0)
  #define VRDS(s,i,base) do{ vlo[s]=vtr(base+(((i)>>2)*4096+((i)&3)*1024)); vhi[s]=vtr(base+(((i)>>2)*4096+((i)&3)*1024+512)); SBAR(); }while(0)
  #define VFS(s) (bf16x8){vlo[s][0],vlo[s][1],vlo[s][2],vlo[s][3],vhi[s][0],vhi[s][1],vhi[s][2],vhi[s][3]}
  #define VRD(i) do{ if constexpr(V128){ if(((i)&3)<2){ vlo[((i)&3)*2+((i)>>2)]=vtr(vp_+(((i)>>2)*4096+((i)&3)*1024)); vhi[((i)&3)*2+((i)>>2)]=vtr(vp_+(((i)>>2)*4096+((i)&3)*1024+512)); } } else { vlo[i]=vtr(vp_+(((i)>>2)*4096+((i)&3)*1024)); vhi[i]=vtr(vp_+(((i)>>2)*4096+((i)&3)*1024+512)); } }while(0)
  #define KRD(G,j) do{ if(G){ kload2(kf,kp0+sl_next,j); SBAR(); } }while(0)
  #define STEP(C0,C1,P0,P1,t,GK,GV,GL) do{ SBAR(); \
    const lds_cptr vp_=vp0+sl_prev; \
    VRD(0); SBAR(); float sacc=(P0[0]+P0[1]); \
    GAPA(C0=__builtin_amdgcn_mfma_f32_32x32x16_bf16(kf[0],qr[0],CINIT,0,0,0), P0[2],P0[3],P0[4],P0[5],     pw0[0]=PKW(P0,0), pw0[1]=PKW(P0,2), pw0); \
    VRD(4); SBAR(); GAPA(C1=__builtin_amdgcn_mfma_f32_32x32x16_bf16(kf[1],qr[0],CINIT,0,0,0), P0[6],P0[7],P0[8],P0[9],     pw0[2]=PKW(P0,4), pw0[3]=PKW(P0,6), pw0); \
    VRD(1); SBAR(); GAPA(C0=__builtin_amdgcn_mfma_f32_32x32x16_bf16(kf[2],qr[1],C0,0,0,0),   P0[10],P0[11],P0[12],P0[13], pw1[0]=PKW(P0,8), pw1[1]=PKW(P0,10), pw1); \
    VRD(5); SBAR(); GAPA(C1=__builtin_amdgcn_mfma_f32_32x32x16_bf16(kf[3],qr[1],C1,0,0,0),   P0[14],P0[15],P1[0],P1[1],   pw1[2]=PKW(P0,12),pw1[3]=PKW(P0,14), pw1); \
    VRD(2); SBAR(); GAPA(C0=__builtin_amdgcn_mfma_f32_32x32x16_bf16(kf[4],qr[2],C0,0,0,0),   P1[2],P1[3],P1[4],P1[5],     pw2[0]=PKW(P1,0), pw2[1]=PKW(P1,2), pw2); \
    VRD(6); SBAR(); GAPA(C1=__builtin_amdgcn_mfma_f32_32x32x16_bf16(kf[5],qr[2],C1,0,0,0),   P1[6],P1[7],P1[8],P1[9],     pw2[2]=PKW(P1,4), pw2[3]=PKW(P1,6), pw2); \
    VRD(3); SBAR(); GAPA(C0=__builtin_amdgcn_mfma_f32_32x32x16_bf16(kf[6],qr[3],C0,0,0,0),   P1[10],P1[11],P1[12],P1[13], pw3[0]=PKW(P1,8), pw3[1]=PKW(P1,10), pw3); \
    VRD(7); SBAR(); GAPA(C1=__builtin_amdgcn_mfma_f32_32x32x16_bf16(kf[7],qr[3],C1,0,0,0),   P1[14],P1[15],0.f,0.f,       pw3[2]=PKW(P1,12),pw3[3]=PKW(P1,14), pw3); \
    l_reg+=sacc; \
    if(GK){DMA_K((t)+3,sl_cur);} if(GV){DMA_V((t)+1,sl_next);} \
    CMASK(C0,C1,t); \
    { float a=MX3(C0[0],C0[1],C1[0]),b=MX3(C0[2],C0[3],C1[1]); a=MX3(a,C1[2],C1[3]); \
      _Pragma("unroll") for(int r=4;r<16;r+=4){a=MX3(a,C0[r],C0[r+1]);b=MX3(b,C0[r+2],C0[r+3]);a=MX3(a,C1[r],C1[r+1]);b=MX3(b,C1[r+2],C1[r+3]);} \
      float rm=__builtin_fmaxf(a,b); { auto rr=__builtin_amdgcn_permlane32_swap(__float_as_uint(rm),__float_as_uint(rm),false,false); rm=__builtin_fmaxf(__uint_as_float(rr[0]),__uint_as_float(rr[1])); } \
      resc=false; \
      if(__builtin_expect(__any(rm>(float)THRL),0)){ const float dl=__builtin_fmaxf(rm,0.f); mhat+=dl; \
        _Pragma("unroll") for(int r=0;r<16;++r){C0[r]-=dl;C1[r]-=dl;} \
        if constexpr(true){ { const float nv_=(MOBA&&!active)?-INFINITY:-mhat; _Pragma("unroll") for(int r=0;r<16;++r)negm[r]=nv_; } asm volatile("":"+v"(negm)); } \
        const float f=__builtin_amdgcn_exp2f(-dl); l_reg*=f; if(hi==0)wsf[r32]=f; resc=true; } } \
    SBAR(); \
    if constexpr(V128){ const lds_cptr vp2_=vp_+(LDS_V2-LDS_V); \
    GAPB2(o[0]=__builtin_amdgcn_mfma_f32_32x32x16_bf16(PAF(0),VFS(0),o[0],0,0,0), C0,0); VRDS(0,2,vp_); \
    GAPB2(o[1]=__builtin_amdgcn_mfma_f32_32x32x16_bf16(PAF(0),VFS(1),o[1],0,0,0), C0,2); VRDS(1,6,vp_); \
    KRD(GL,0); GAPB2(o[0]=__builtin_amdgcn_mfma_f32_32x32x16_bf16(PAF(1),VFS(2),o[0],0,0,0), C0,4); VRDS(2,3,vp_); \
    KRD(GL,1); GAPB2(o[1]=__builtin_amdgcn_mfma_f32_32x32x16_bf16(PAF(1),VFS(3),o[1],0,0,0), C0,6); VRDS(3,7,vp_); \
    KRD(GL,2); GAPB2(o[0]=__builtin_amdgcn_mfma_f32_32x32x16_bf16(PAF(2),VFS(0),o[0],0,0,0), C0,8); VRDS(0,0,vp2_); \
    KRD(GL,3); GAPB2(o[1]=__builtin_amdgcn_mfma_f32_32x32x16_bf16(PAF(2),VFS(1),o[1],0,0,0), C0,10); VRDS(1,4,vp2_); \
    GAPB2(o[0]=__builtin_amdgcn_mfma_f32_32x32x16_bf16(PAF(3),VFS(2),o[0],0,0,0), C0,12); VRDS(2,1,vp2_); \
    GAPB2(o[1]=__builtin_amdgcn_mfma_f32_32x32x16_bf16(PAF(3),VFS(3),o[1],0,0,0), C0,14); VRDS(3,5,vp2_); \
    GAPB2(o[2]=__builtin_amdgcn_mfma_f32_32x32x16_bf16(PAF(0),VFS(0),o[2],0,0,0), C1,0); VRDS(0,2,vp2_); \
    GAPB2(o[3]=__builtin_amdgcn_mfma_f32_32x32x16_bf16(PAF(0),VFS(1),o[3],0,0,0), C1,2); VRDS(1,6,vp2_); \
    GAPB2(o[2]=__builtin_amdgcn_mfma_f32_32x32x16_bf16(PAF(1),VFS(2),o[2],0,0,0), C1,4); VRDS(2,3,vp2_); \
    GAPB2(o[3]=__builtin_amdgcn_mfma_f32_32x32x16_bf16(PAF(1),VFS(3),o[3],0,0,0), C1,6); VRDS(3,7,vp2_); \
    GAPB2(o[2]=__builtin_amdgcn_mfma_f32_32x32x16_bf16(PAF(2),VFS(0),o[2],0,0,0), C1,8); \
    GAPB2(o[3]=__builtin_amdgcn_mfma_f32_32x32x16_bf16(PAF(2),VFS(1),o[3],0,0,0), C1,10); \
    GAPB2(o[2]=__builtin_amdgcn_mfma_f32_32x32x16_bf16(PAF(3),VFS(2),o[2],0,0,0), C1,12); \
    GAPB2(o[3]=__builtin_amdgcn_mfma_f32_32x32x16_bf16(PAF(3),VFS(3),o[3],0,0,0), C1,14); \
    } else { \
    GAPB(o[0]=__builtin_amdgcn_mfma_f32_32x32x16_bf16(PAF(0),VFR(0),o[0],0,0,0), C0,0); \
    GAPB(o[1]=__builtin_amdgcn_mfma_f32_32x32x16_bf16(PAF(0),VFR(4),o[1],0,0,0), C0,4); \
    KRD(GL,0); GAPB(o[0]=__builtin_amdgcn_mfma_f32_32x32x16_bf16(PAF(1),VFR(1),o[0],0,0,0), C0,8); \
    KRD(GL,1); GAPB(o[1]=__builtin_amdgcn_mfma_f32_32x32x16_bf16(PAF(1),VFR(5),o[1],0,0,0), C0,12); \
    KRD(GL,2); GAPB(o[0]=__builtin_amdgcn_mfma_f32_32x32x16_bf16(PAF(2),VFR(2),o[0],0,0,0), C1,0); \
    KRD(GL,3); GAPB(o[1]=__builtin_amdgcn_mfma_f32_32x32x16_bf16(PAF(2),VFR(6),o[1],0,0,0), C1,4); \
    GAPB(o[0]=__builtin_amdgcn_mfma_f32_32x32x16_bf16(PAF(3),VFR(3),o[0],0,0,0), C1,8); \
    GAPB(o[1]=__builtin_amdgcn_mfma_f32_32x32x16_bf16(PAF(3),VFR(7),o[1],0,0,0), C1,12); \
    } \
    }while(0)
  int t=1;
  #undef CMASK
  #define CMASK(P0,P1,t) do{}while(0)
  for(;t+5<NT;t+=2){
    STEP(pB0,pB1,pA0,pA1,t,true,true,true);     WAIT_STEP(); RESC(); ROT(); BLK(t+1);
    STEP(pA0,pA1,pB0,pB1,t+1,true,true,true);   WAIT_STEP(); RESC(); ROT();
  }
  #undef CMASK
  #define CMASK(P0,P1,t) do{int jb_=(t)-(NT-4); if(jb_>=0)cmask(P0,P1,jb_,qrel,hi);}while(0)
  #define ENDW(tt) do{ if constexpr(V128){ if((tt)+3<NT){WAIT_BAR(3);} else if((tt)+2<NT){WAIT_BAR(2);} else {WAIT_BAR(0);} } else { if((tt)+3<NT){WAIT_BAR(2);} else if((tt)+2<NT){WAIT_BAR(1);} else {WAIT_BAR(0);} } }while(0)
  for(;t+1<NT;t+=2){
    STEP(pB0,pB1,pA0,pA1,t,(t+3<NT),(t+1<NT),(t+1<NT));       ENDW(t);   RESC(); ROT(); BLK(t+1);
    STEP(pA0,pA1,pB0,pB1,t+1,(t+4<NT),(t+2<NT),(t+2<NT));     ENDW(t+1); RESC(); ROT();
  }
  STEP(pB0,pB1,pA0,pA1,NT-1,false,false,false); RESC();
  { float sacc=pB0[0]+pB0[1]; _Pragma("unroll") for(int r=2;r<16;++r)sacc+=pB0[r]; _Pragma("unroll") for(int r=0;r<16;++r)sacc+=pB1[r]; l_reg+=sacc;
    pw0=(u32x4){PKW(pB0,0),PKW(pB0,2),PKW(pB0,4),PKW(pB0,6)};pw1=(u32x4){PKW(pB0,8),PKW(pB0,10),PKW(pB0,12),PKW(pB0,14)};pw2=(u32x4){PKW(pB1,0),PKW(pB1,2),PKW(pB1,4),PKW(pB1,6)};pw3=(u32x4){PKW(pB1,8),PKW(pB1,10),PKW(pB1,12),PKW(pB1,14)};
    SBAR(); pv(o,vb0+sl_cur,PAF(0),PAF(1),PAF(2),PAF(3)); if constexpr(V128){ SBAR(); pv(o+2,vb0+sl_cur+(LDS_V2-LDS_V),PAF(0),PAF(1),PAF(2),PAF(3)); } }
  #undef PKW
  #undef PAF
  #undef VFR
  #undef PIN
  #undef MX3
  #undef GAPA
  #undef GAPB
  #undef GAPB2
  #undef CINIT
  #undef VRDS
  #undef VFS
  #undef EX
  #undef VRD
  #undef KRD
  #undef STEP
  #undef ENDW
  {auto rr=__builtin_amdgcn_permlane32_swap(__float_as_uint(l_reg),__float_as_uint(l_reg),false,false);l_reg=__uint_as_float(rr[0])+__uint_as_float(rr[1]);}
  if(hi==0)wsf[32+r32]=l_reg;asm volatile("s_waitcnt lgkmcnt(0)":::"memory");
  float rli[16];
  #pragma unroll
  for(int r=0;r<16;++r)rli[r]=__builtin_amdgcn_rcpf(wsf[32+crow(r,hi)]);
  bf16*Ow=Oh+(long)(q0+wid*QBLK)*DM; const bf16*Gw=MOBA?Gh+(long)(q0+wid*QBLK)*DM:nullptr;
  _Pragma("unroll") for(int hp=0;hp<(V128?2:1);++hp)
  { bf16*stg=(bf16*)(shm+LDS_OST)+wid*2048;
    #pragma unroll
    for(int r=0;r<16;++r){const int orow=crow(r,hi);
      #pragma unroll
      for(int d0=0;d0<2;++d0)stg[orow*64+d0*32+r32]=__float2bfloat16(o[2*hp+d0][r]*rli[r]);}
    asm volatile("s_waitcnt lgkmcnt(0)":::"memory");
    #pragma unroll
    for(int i=0;i<4;++i){const int row=i*8+(lane>>3),ch=lane&7; u32x4 v=*(const u32x4*)(stg+row*64+ch*8);
      if constexpr(MOBA){ const u32x4 gg=__builtin_nontemporal_load((const u32x4*)(Gw+(long)row*DM+ch*8));
        _Pragma("unroll") for(int k=0;k<4;++k){ const float lo=__uint_as_float(v[k]<<16)*__uint_as_float(gg[k]<<16), hi_=__uint_as_float(v[k]&0xffff0000u)*__uint_as_float(gg[k]&0xffff0000u); v[k]=cvtpk_s(lo,hi_);} }
      ATTN_STORE16(Ow+(long)row*DM+hp*64+ch*8,v);}
    asm volatile("s_waitcnt lgkmcnt(0)":::"memory"); }
  asm volatile("s_waitcnt lgkmcnt(0)\n\ts_barrier":::"memory");
  #undef DMA_K
  #undef DMA_V
  #undef WAIT_STEP
  #undef CMASK
  #undef START
  #undef RESC
  #undef ROT
  #undef MOBA_STAGE
  #undef MOBA_GATE
  #undef MOBA_T0
  #undef BLK
}
constexpr int ATTN_LDS_BYTES=LDS_BYTES;
#undef SBAR
#undef WAIT_BAR
}
constexpr int NWAVES = 8;
constexpr int BATCH = 2, T = 8192, D = 1024, M = BATCH * T, NIN = 6144, PLE = 256, DW = 512;
constexpr size_t MiB = 1u << 20;
constexpr size_t WS_CTL = 0, CTL_ZERO_BYTES = 1 * MiB, WS_KMEAN = 512 * 1024;
constexpr size_t WS_WIN = 2 * MiB, WS_WD = 14 * MiB, WS_WM = 15 * MiB, WS_WO = 16 * MiB, WS_WG = 18 * MiB, WS_WP = 20 * MiB, WS_ROPE = 21 * MiB, WS_PB = 22 * MiB;
constexpr size_t WS_XN = 32 * MiB;
constexpr size_t WS_DQ = 64 * MiB, WS_DK = 80 * MiB, WS_DV = 96 * MiB, WS_DG = 112 * MiB, WS_MQ = 128 * MiB, WS_MK = 144 * MiB, WS_MV = 160 * MiB, WS_MG = 176 * MiB;
constexpr size_t WS_GA = 192 * MiB, WS_GB = 224 * MiB, WS_END = 256 * MiB;
constexpr size_t WS_OA = WS_DQ;
constexpr size_t WS_MERGED = WS_DK;
constexpr size_t WS_X1B = WS_MK;
constexpr int CW_Q = 16320;
constexpr int CW_LOC = 12288;
constexpr int CW_BAR = 4096, CW_SEAM = 8192;
constexpr size_t WS_XBUF = 640 * 1024;
constexpr int RING_OFF = 0, RING_BYTES = 131072;
constexpr int LDSCTL_OFF = RING_BYTES, MISC_OFF = LDSCTL_OFF + 320;
constexpr int LDS_BYTES = 147456;

#define GAS __attribute__((address_space(1)))
#define LAS __attribute__((address_space(3)))
typedef unsigned short bf16;
typedef unsigned v4u __attribute__((ext_vector_type(4)));
typedef unsigned v2u __attribute__((ext_vector_type(2)));
typedef float f32x4 __attribute__((ext_vector_type(4)));
#define LDS_WAIT() asm volatile("s_waitcnt lgkmcnt(0)" ::: "memory")
#define VM_WAIT() asm volatile("s_waitcnt vmcnt(0)" ::: "memory")
__device__ __forceinline__ unsigned f2bf(float f) { unsigned u = __builtin_bit_cast(unsigned, f); return (u + 0x7fffu + ((u >> 16) & 1u)) >> 16; }
__device__ __forceinline__ unsigned pk2(float lo, float hi) { return f2bf(lo) | (f2bf(hi) << 16); }
__device__ __forceinline__ float blo(unsigned w) { return __uint_as_float(w << 16); }
__device__ __forceinline__ float bhi(unsigned w) { return __uint_as_float(w & 0xffff0000u); }

struct Frame {
    LAS unsigned char* lds;
    int tid, lane, wave, vcu, G;
};
struct Args { const float* in[15]; float* out; unsigned char* ws; };
typedef const __attribute__((address_space(4))) Args* KArgs;
__device__ __forceinline__ KArgs kargs_ptr() { KArgs a = (KArgs)__builtin_amdgcn_kernarg_segment_ptr(); asm volatile("" : "+s"(a)); return a; }
__device__ __forceinline__ Frame mk_frame(unsigned char* lds, int wv) {
    Frame F; F.lds = (LAS unsigned char*)lds;
    asm volatile("" : "+s"(wv));
    int tid = wv * 64 + lane_id_opaque(); asm volatile("" : "+v"(tid));
    int bx = blockIdx.x, G = gridDim.x; asm volatile("" : "+s"(bx), "+s"(G));
    F.tid = tid; F.lane = tid & 63; F.wave = wv;
    F.G = G; F.vcu = (G % 8 == 0) ? (bx % 8) * (G / 8) + bx / 8 : bx;
    return F;
}
__device__ __forceinline__ float wave_sum(float v) {
    v += swz_xor<1>(v); v += swz_xor<2>(v); v += swz_xor<4>(v); v += swz_xor<8>(v); v += swz_xor<16>(v);
    return half_sum(v);
}
__device__ __forceinline__ void p0_transpose_item(const float* W, int K, int N, bf16* WT, LAS float* scr, int item, int lane) {
    const int nblk = N / 32, kb = item / nblk, nb = item % nblk, k0 = 64 * kb, n0 = 32 * nb;
#pragma unroll 16
    for (int i = 0; i < 32; ++i) { const int kk = 2 * i + (lane >> 5); scr[kk * 33 + (lane & 31)] = __builtin_nontemporal_load(W + (size_t)(k0 + kk) * N + n0 + (lane & 31)); }
    LDS_WAIT(); asm volatile("" ::: "memory");
    const int c = lane & 7;
#pragma unroll
    for (int j = 0; j < 4; ++j) { const int n = (lane >> 3) + 8 * j; const LAS float* s = scr + (8 * c) * 33 + n;
        v4u o; o.x = pk2(s[0 * 33], s[1 * 33]); o.y = pk2(s[2 * 33], s[3 * 33]); o.z = pk2(s[4 * 33], s[5 * 33]); o.w = pk2(s[6 * 33], s[7 * 33]);
        *(GAS v4u*)(WT + (size_t)(n0 + n) * K + k0 + 8 * c) = o; }
    LDS_WAIT(); asm volatile("" ::: "memory");
}
__constant__ float ROPE_INV[8] = {1.0f, 0.1939227432012558f, 0.03760603070259094f, 0.007292664609849453f, 0.0014142135623842478f, 0.00027424818836152554f, 5.318296098266728e-05f, 1.0313386155758053e-05f};

__device__ __forceinline__ void p0_prologue(unsigned char* ldsp, int wv) {
    Frame F = mk_frame(ldsp, wv); KArgs ka = kargs_ptr();
    unsigned char* ws = ka->ws;
    LAS float* scr = (LAS float*)(F.lds + RING_OFF + F.wave * 16384);
    const int gw = F.vcu * NWAVES + F.wave, NGW = F.G * NWAVES;
    constexpr int I_IN = (D / 64) * (NIN / 32), I_D = (DW / 64) * (D / 32), I_O = (D / 64) * (D / 32), I_P = (PLE / 64) * (D / 32);
    (void)I_D; (void)I_O; (void)I_P;
    for (int it = gw; it < I_IN; it += NGW) p0_transpose_item(ka->in[3], D, NIN, (bf16*)(ws + WS_WIN), scr, it, F.lane);
    {
        const GAS f32x4* gp = (const GAS f32x4*)ka->in[2] + F.lane; f32x4 gv[4];
#pragma unroll
        for (int j = 0; j < 4; ++j) gv[j] = gp[64 * j];
        for (int m = gw; m < M; m += 2 * NGW) {
            const int m2 = m + NGW; const bool has2 = m2 < M; const int mb = has2 ? m2 : m;
            const GAS f32x4* xr = (const GAS f32x4*)(ka->in[0] + (size_t)m * D) + F.lane; const GAS f32x4* xr2 = (const GAS f32x4*)(ka->in[0] + (size_t)mb * D) + F.lane;
            f32x4 v[4], w[4]; float s = 0.f, s2 = 0.f;
#pragma unroll
            for (int j = 0; j < 4; ++j) { v[j] = __builtin_nontemporal_load(xr + 64 * j); w[j] = __builtin_nontemporal_load(xr2 + 64 * j); }
#pragma unroll
            for (int j = 0; j < 4; ++j) { s += (v[j].x * v[j].x + v[j].y * v[j].y) + (v[j].z * v[j].z + v[j].w * v[j].w); s2 += (w[j].x * w[j].x + w[j].y * w[j].y) + (w[j].z * w[j].z + w[j].w * w[j].w); }
            const float rstd = 1.f / sqrtf(wave_sum(s) * (1.f / D) + 1e-6f), rstd2 = 1.f / sqrtf(wave_sum(s2) * (1.f / D) + 1e-6f);
            GAS unsigned long long* o8 = (GAS unsigned long long*)(ws + WS_XN + (size_t)m * D * 2) + F.lane;
#pragma unroll
            for (int j = 0; j < 4; ++j) { const f32x4 y = v[j] * rstd * gv[j]; o8[64 * j] = (unsigned long long)pk2(y.x, y.y) | ((unsigned long long)pk2(y.z, y.w) << 32); }
            if (has2) { GAS unsigned long long* p8 = (GAS unsigned long long*)(ws + WS_XN + (size_t)m2 * D * 2) + F.lane;
#pragma unroll
                for (int j = 0; j < 4; ++j) { const f32x4 y = w[j] * rstd2 * gv[j]; p8[64 * j] = (unsigned long long)pk2(y.x, y.y) | ((unsigned long long)pk2(y.z, y.w) << 32); } }
        }
    }
    for (int idx = gw * 64 + F.lane; idx < T * 8; idx += NGW * 64) {
        const int pos = idx >> 3, j = idx & 7; const float ang = (float)pos * ROPE_INV[j];
        const double a = (double)ang; const double k = rint(a * 0.15915494309189535); const float r = (float)(a - k * 6.283185307179586);
        float* tp = (float*)(ws + WS_ROPE) + (size_t)pos * 16 + j; tp[0] = cosf(r); tp[8] = sinf(r);
    }
    for (int idx = gw * 64 + F.lane; idx < 2 * 8 * 32 * 64; idx += NGW * 64) ((float*)(ws + WS_KMEAN))[idx] = 0.f;
}

__device__ __forceinline__ void p2_pre(unsigned char* ldsp, int wv) {
    Frame F = mk_frame(ldsp, wv); KArgs ka = kargs_ptr();
    unsigned char* ws = ka->ws;
    LAS float* scr = (LAS float*)(F.lds + RING_OFF + F.wave * 16384);
    const int gw = F.vcu * NWAVES + F.wave, NGW = F.G * NWAVES;
    constexpr int I_D = (DW / 64) * (D / 32), I_O = (D / 64) * (D / 32), I_P = (PLE / 64) * (D / 32);
    constexpr int NITEMS = 2 * I_D + 2 * I_O + I_P;
    for (int it = gw; it < NITEMS; it += NGW) {
        int r = it;
        if (r < I_D) { p0_transpose_item(ka->in[9], DW, D, (bf16*)(ws + WS_WD), scr, r, F.lane); continue; } r -= I_D;
        if (r < I_D) { p0_transpose_item(ka->in[10], DW, D, (bf16*)(ws + WS_WM), scr, r, F.lane); continue; } r -= I_D;
        if (r < I_O) { p0_transpose_item(ka->in[11], D, D, (bf16*)(ws + WS_WO), scr, r, F.lane); continue; } r -= I_O;
        if (r < I_O) { p0_transpose_item(ka->in[13], D, D, (bf16*)(ws + WS_WG), scr, r, F.lane); continue; } r -= I_O;
        p0_transpose_item(ka->in[12], PLE, D, (bf16*)(ws + WS_WP), scr, r, F.lane);
    }
    for (int m = gw; m < M; m += NGW) {
        const f32x4 v = __builtin_nontemporal_load((const GAS f32x4*)(ka->in[1] + (size_t)m * PLE) + F.lane);
        *((GAS unsigned long long*)(ws + WS_PB + (size_t)m * PLE * 2) + F.lane) = (unsigned long long)pk2(v.x, v.y) | ((unsigned long long)pk2(v.z, v.w) << 32);
    }
    LDS_WAIT(); __syncthreads();
}
__device__ __forceinline__ void p2_attention(unsigned char* ldsg, int wv) {
    Frame F = mk_frame(ldsg, wv); unsigned char* ws = kargs_ptr()->ws;
    using abf = attn_body::bf16;
    volatile LAS unsigned* MI = (volatile LAS unsigned*)(F.lds + MISC_OFF);
    unsigned* qhead = (unsigned*)(ws + WS_CTL) + CW_Q;
    const int nP = (F.vcu < 256) ? (256 - F.vcu + F.G - 1) / F.G : 0;
    for (int task = 0; ; ++task) {
        int type, st, qb;
        if (task < 2 * nP) { const int P = F.vcu + (task >> 1) * F.G; type = task & 1; st = P >> 4; qb = 31 - (P & 15); }
        else {
            if (F.tid == 0) MI[14] = __hip_atomic_fetch_add(qhead, 1u, __ATOMIC_RELAXED, __HIP_MEMORY_SCOPE_AGENT);
            __syncthreads();
            const unsigned idx = MI[14];
            __syncthreads();
            if (idx >= 512u) break;
            type = (int)(idx >> 4) & 1; st = (int)idx & 15; qb = 15 - (int)(idx >> 5);
        }
        if (type == 0) { const int mm = st & 1, h = (st >> 1) & 3, b = st >> 3; const size_t rb = (size_t)b * T * DW;
            const abf* Q = (const abf*)(ws + WS_DQ) + rb + (2 * h + mm) * 64; const abf* K = (const abf*)(ws + WS_DK) + rb + (2 * h + mm) * 64;
            const abf* V = (const abf*)(ws + WS_DV) + rb + h * 128; abf* O = (abf*)(ws + WS_XN) + (size_t)mm * M * DW + rb + h * 128;
            attn_body::attn_unit<8, false, true>(qb, Q, K, V, O, nullptr, nullptr, (char*)ldsg, F.wave);
        } else { const int b = st >> 3, h = st & 7; const size_t rb = (size_t)b * T * DW + h * 64;
            abf* Q = (abf*)(ws + WS_MQ) + rb; const abf* K = (const abf*)(ws + WS_MK) + rb; const abf* V = (const abf*)(ws + WS_MV) + rb; const abf* Gt = (const abf*)(ws + WS_MG) + rb;
            const float* km = (const float*)(ws + WS_KMEAN) + (size_t)((b * 8 + h) * 32) * 64;
            attn_body::attn_unit<8, true, false>(qb, Q, K, V, Q, Gt, km, (char*)ldsg, F.wave);
        }
    }
}

__device__ __forceinline__ void p3_combine(unsigned char* ldsp, int wv) {
    Frame F = mk_frame(ldsp, wv); KArgs ka = kargs_ptr();
    unsigned char* ws = ka->ws;
    int gw = F.vcu * NWAVES + F.wave, NGW = F.G * NWAVES, rbase = 0, rend = M;
    { volatile LAS unsigned* MI = (volatile LAS unsigned*)(F.lds + MISC_OFF);
      if (MI[10]) { const int xl = (int)MI[11] >> 3, r = ((int)MI[11] & 7) + 8 * (int)MI[12]; rbase = 2048 * xl; rend = 2048; gw = r * NWAVES + F.wave; NGW = 32 * NWAVES; } }
    const float d1 = wave_sum(ka->in[4][F.lane] * ka->in[5][F.lane]), d2 = wave_sum(ka->in[6][F.lane] * ka->in[7][F.lane]);
    const float lam_init = 0.2f, lam = expf(d1) - expf(d2) + lam_init;
    const int e0 = (8 * F.lane) & 127; float sg[8];
#pragma unroll
    for (int i = 0; i < 8; ++i) sg[i] = ka->in[8][e0 + i] * (1.0f - lam_init);
    for (int m0 = gw; m0 < rend; m0 += 2 * NGW) {
        v4u a[2], b[2], g[2]; size_t off[2]; const bool has2 = (m0 + NGW) < rend;
#pragma unroll
        for (int q = 0; q < 2; ++q) { const int m = rbase + ((q && has2) ? m0 + NGW : m0); off[q] = (size_t)m * DW + 8 * F.lane;
            a[q] = __builtin_nontemporal_load((const GAS v4u*)((const bf16*)(ws + WS_XN) + off[q])); b[q] = __builtin_nontemporal_load((const GAS v4u*)((const bf16*)(ws + WS_XN) + (size_t)M * DW + off[q])); g[q] = __builtin_nontemporal_load((const GAS v4u*)((const bf16*)(ws + WS_DG) + off[q])); }
#pragma unroll
        for (int q = 0; q < 2; ++q) { if (q && !has2) break;
            float d[8]; float ss = 0.f;
#pragma unroll
            for (int k = 0; k < 4; ++k) { d[2 * k] = blo(a[q][k]) - lam * blo(b[q][k]); d[2 * k + 1] = bhi(a[q][k]) - lam * bhi(b[q][k]); ss += d[2 * k] * d[2 * k] + d[2 * k + 1] * d[2 * k + 1]; }
            ss += swz_xor<1>(ss); ss += swz_xor<2>(ss); ss += swz_xor<4>(ss); ss += swz_xor<8>(ss);
            const float rstd = 1.f / sqrtf(ss * (1.f / 128.f) + 1e-5f);
            v4u o;
#pragma unroll
            for (int k = 0; k < 4; ++k) o[k] = pk2(d[2 * k] * rstd * sg[2 * k] * blo(g[q][k]), d[2 * k + 1] * rstd * sg[2 * k + 1] * bhi(g[q][k]));
            *(GAS v4u*)((bf16*)(ws + WS_OA) + off[q]) = o; }
    }
}
__device__ __forceinline__ void p7_final(unsigned char* ldsp, int wv) {
    Frame F = mk_frame(ldsp, wv); KArgs ka = kargs_ptr();
    const int gw = F.vcu * NWAVES + F.wave, NGW = F.G * NWAVES;
    const GAS f32x4* gp = (const GAS f32x4*)ka->in[14] + F.lane; f32x4 gv[4];
#pragma unroll
    for (int j = 0; j < 4; ++j) gv[j] = gp[64 * j];
    for (int m = gw; m < M; m += NGW) {
        GAS f32x4* xr = (GAS f32x4*)(ka->out + (size_t)m * D) + F.lane; f32x4 v[4]; float s = 0.f;
#pragma unroll
        for (int j = 0; j < 4; ++j) { v[j] = xr[64 * j]; s += (v[j].x * v[j].x + v[j].y * v[j].y) + (v[j].z * v[j].z + v[j].w * v[j].w); }
        const float rstd = 1.f / sqrtf(wave_sum(s) * (1.f / D) + 1e-6f);
#pragma unroll
        for (int j = 0; j < 4; ++j) xr[64 * j] = v[j] * rstd * gv[j];
    }
}

__device__ __forceinline__ void p1_inproj(unsigned char* ldsp, int wv) {
    Frame F = mk_frame(ldsp, wv); unsigned char* ws = kargs_ptr()->ws;
    pg8::Gemm g{(const pg8::bf16_t*)(ws + WS_XN), (const pg8::bf16_t*)(ws + WS_WIN), nullptr, nullptr, M, NIN, D};
    pg8::StaticOrder S; S.init(M, NIN, F.G, (int)blockIdx.x);
    pg8::EpiInProj E{ws + WS_DQ, ws + WS_GA, (const float*)(ws + WS_ROPE), (float*)(ws + WS_KMEAN), attn_body::C2};
    pg8::gemm_phase<pg8::EpiInProj, pg8::StaticOrder, true, true>(F.lds + RING_OFF, g, S, E, F.wave);
}
__device__ __forceinline__ void p4a_ple(unsigned char* ldsp, int wv) {
    Frame F = mk_frame(ldsp, wv); unsigned char* ws = kargs_ptr()->ws;
    pg8::Gemm g{(const pg8::bf16_t*)(ws + WS_PB), (const pg8::bf16_t*)(ws + WS_WP), nullptr, nullptr, M, D, PLE};
    pg8::StaticOrder S; S.init(M, D, F.G, (int)blockIdx.x); { volatile LAS unsigned* MI = (volatile LAS unsigned*)(F.lds + MISC_OFF); if (MI[10]) S.fix((int)MI[11], (int)MI[12]); }
    const bool in_out = F.G == 256;
    pg8::EpiStore E{in_out ? (pg8::bf16_t*)kargs_ptr()->out : (pg8::bf16_t*)(ws + WS_XN), in_out ? 2 * D : D, in_out ? 512 : 256};
    pg8::gemm_phase<pg8::EpiStore, pg8::StaticOrder, true, true>(F.lds + RING_OFF, g, S, E, F.wave);
}
__device__ __forceinline__ void p4b_branches(unsigned char* ldsp, int wv) {
    Frame F = mk_frame(ldsp, wv); unsigned char* ws = kargs_ptr()->ws;
    pg8::Gemm g{(const pg8::bf16_t*)(ws + WS_OA), (const pg8::bf16_t*)(ws + WS_WD), (const pg8::bf16_t*)(ws + WS_MQ), (const pg8::bf16_t*)(ws + WS_WM), M, D, DW};
    pg8::PairOrder S; S.init(M, D, F.G, (int)blockIdx.x); { volatile LAS unsigned* MI = (volatile LAS unsigned*)(F.lds + MISC_OFF); if (MI[10]) S.s.fix((int)MI[11], (int)MI[12]); }
    pg8::EpiMerge E{(const pg8::bf16_t*)(ws + WS_GA), (const pg8::bf16_t*)(ws + WS_GB), (pg8::bf16_t*)(ws + WS_MERGED)};
    pg8::gemm_phase<pg8::EpiMerge, pg8::PairOrder, true, true>(F.lds + RING_OFF, g, S, E, F.wave);
}
__device__ __forceinline__ void p5_out(unsigned char* ldsp, int wv) {
    Frame F = mk_frame(ldsp, wv); KArgs ka = kargs_ptr(); unsigned char* ws = ka->ws;
    pg8::Gemm g{(const pg8::bf16_t*)(ws + WS_MERGED), (const pg8::bf16_t*)(ws + WS_WO), nullptr, nullptr, M, D, D};
    pg8::StaticOrder S; S.init(M, D, F.G, (int)blockIdx.x); { volatile LAS unsigned* MI = (volatile LAS unsigned*)(F.lds + MISC_OFF); if (MI[10]) S.fix((int)MI[11], (int)MI[12]); }
    if (F.G == 256) {
        pg8::EpiResid<false> E{ka->in[0], ka->out, (pg8::bf16_t*)(ws + WS_X1B)};
        pg8::gemm_phase<pg8::EpiResid<false>, pg8::StaticOrder, true, true>(F.lds + RING_OFF, g, S, E, F.wave);
    } else {
        pg8::EpiResid<true> E{ka->in[0], ka->out, (pg8::bf16_t*)(ws + WS_X1B)};
        pg8::gemm_phase<pg8::EpiResid<true>, pg8::StaticOrder, true, true>(F.lds + RING_OFF, g, S, E, F.wave);
    }
}
__device__ __forceinline__ void p6_ple(unsigned char* ldsp, int wv) {
    Frame F = mk_frame(ldsp, wv); KArgs ka = kargs_ptr(); unsigned char* ws = ka->ws;
    pg8::Gemm g{(const pg8::bf16_t*)(ws + WS_X1B), (const pg8::bf16_t*)(ws + WS_WG), nullptr, nullptr, M, D, D};
    pg8::StaticOrder S; S.init(M, D, F.G, (int)blockIdx.x); { volatile LAS unsigned* MI = (volatile LAS unsigned*)(F.lds + MISC_OFF); if (MI[10]) S.fix((int)MI[11], (int)MI[12]); }
    if (F.G == 256) {
        pg8::EpiPleNorm E{ka->out, (const pg8::bf16_t*)(ws + WS_X1B), (const pg8::bf16_t*)ka->out, ka->in[14], (float*)(ws + WS_XBUF), (unsigned*)(ws + WS_CTL) + CW_SEAM};
        pg8::gemm_phase<pg8::EpiPleNorm, pg8::StaticOrder, false, true>(F.lds + RING_OFF, g, S, E, F.wave);
    } else {
        pg8::EpiPle E{ka->out, (const pg8::bf16_t*)(ws + WS_XN)};
        pg8::gemm_phase<pg8::EpiPle, pg8::StaticOrder, true, true>(F.lds + RING_OFF, g, S, E, F.wave);
    }
}

#define XB_TMO      128
#define XB_XCNT(j)  (256  + 64 * (j))
#define XB_XSUB(j)  (1280 + 64 * (j))
#define XB_XGEN(j)  (2304 + 64 * (j))
#define XB_TOP      3328
#define XB_TOPGEN   3392
#define XCD_BAR_WORDS 3456
#define XB_SPIN_CAP (1u << 18)

__device__ __forceinline__ unsigned xb_ld(unsigned* p)              { return __hip_atomic_load(p, __ATOMIC_RELAXED, __HIP_MEMORY_SCOPE_AGENT); }
__device__ __forceinline__ unsigned xb_add(unsigned* p, unsigned v) { return __hip_atomic_fetch_add(p, v, __ATOMIC_RELAXED, __HIP_MEMORY_SCOPE_AGENT); }
__device__ __forceinline__ unsigned xb_xcc_id() { return (unsigned)__builtin_amdgcn_s_getreg((3 << 11) | 20) & 0xFu; }
#define XB_SPIN(cond, bar) do { unsigned _sp = 0; while (cond) { __builtin_amdgcn_s_sleep(1); \
    if ((++_sp & 255u) == 0u) { if (xb_ld(&(bar)[XB_TMO])) break; if (_sp > XB_SPIN_CAP) { atomicAdd(&(bar)[XB_TMO], 1u); break; } } } } while (0)

struct XcdBarrier {
    unsigned* bar; unsigned x;
    volatile LAS unsigned* st;
};

__device__ __forceinline__ XcdBarrier xcd_barrier_post(unsigned* bar, volatile LAS unsigned* st) {
    XcdBarrier b; b.bar = bar; b.x = xb_xcc_id(); b.st = st;
    if (threadIdx.x == 0) (void)xb_add(&bar[XB_XCNT(b.x)], 1u);
    return b;
}
__device__ __forceinline__ void xcd_barrier_complete(unsigned* bar, unsigned x, unsigned& nloc, unsigned& nx) {
    const unsigned G = gridDim.x * gridDim.y * gridDim.z;
    unsigned sum, cnt, mine, sp = 0u;
    for (;;) {
        sum = 0u; cnt = 0u; mine = 0u;
#pragma unroll
        for (unsigned j = 0; j < 16; ++j) { const unsigned c = xb_ld(&bar[XB_XCNT(j)]); sum += c; cnt += (c > 0u) ? 1u : 0u; mine = (j == x) ? c : mine; }
        if (sum == G) break;
        __builtin_amdgcn_s_sleep(1);
        if ((++sp & 255u) == 0u) { if (xb_ld(&bar[XB_TMO])) break; if (sp > XB_SPIN_CAP) { atomicAdd(&bar[XB_TMO], 1u); break; } }
    }
    nloc = mine > 0u ? mine : 1u; nx = cnt > 0u ? cnt : 1u;
}

__device__ __forceinline__ void xcd_barrier(const XcdBarrier& b) {
    asm volatile("s_waitcnt vmcnt(0)" ::: "memory");
    __syncthreads();
    if (threadIdx.x == 0) {
        unsigned* bar = b.bar;
        __builtin_amdgcn_s_waitcnt(0);
        unsigned nloc = b.st[0], nx = b.st[1];
        if (nloc == 0u) { xcd_barrier_complete(bar, b.x, nloc, nx); b.st[0] = nloc; b.st[1] = nx; }
        const unsigned old = xb_add(&bar[XB_XSUB(b.x)], 1u);
        const unsigned gen = old / nloc;
        if (old + 1u == (gen + 1u) * nloc) {
            __builtin_amdgcn_fence(__ATOMIC_RELEASE, "agent");
            asm volatile("s_waitcnt vmcnt(0)" ::: "memory");
            const unsigned og = xb_add(&bar[XB_TOP], 1u);
            const unsigned tg = og / nx;
            if (og + 1u == (tg + 1u) * nx) xb_add(&bar[XB_TOPGEN], 1u);
            else XB_SPIN(xb_ld(&bar[XB_TOPGEN]) == tg, bar);
            __builtin_amdgcn_fence(__ATOMIC_ACQUIRE, "agent");
            xb_add(&bar[XB_XGEN(b.x)], 1u);
            asm volatile("s_waitcnt vmcnt(0)" ::: "memory");
        } else {
            XB_SPIN(xb_ld(&bar[XB_XGEN(b.x)]) == gen, bar);
            __builtin_amdgcn_fence(__ATOMIC_ACQUIRE, "agent");
            asm volatile("s_waitcnt vmcnt(0)" ::: "memory");
        }
    }
    __syncthreads();
}
__device__ __forceinline__ void grid_bar(unsigned char* ldsp) {
    XcdBarrier b; b.bar = (unsigned*)(kargs_ptr()->ws + WS_CTL) + CW_BAR; b.x = xb_xcc_id(); b.st = (volatile LAS unsigned*)((LAS unsigned char*)ldsp + MISC_OFF) + 8;
    xcd_barrier(b);
}
__device__ __forceinline__ void xcc_bar(unsigned char* ldsp) {
    asm volatile("s_waitcnt vmcnt(0)" ::: "memory");
    __syncthreads();
    if (threadIdx.x == 0) {
        unsigned* ctl = (unsigned*)(kargs_ptr()->ws + WS_CTL); const unsigned x = xb_xcc_id();
        __builtin_amdgcn_s_waitcnt(0);
        const unsigned old = xb_add(&ctl[CW_LOC + 64 * x], 1u), gen = old / 32u;
        if (old + 1u == (gen + 1u) * 32u) xb_add(&ctl[CW_LOC + 1024 + 64 * x], 1u);
        else { unsigned sp = 0; while (xb_ld(&ctl[CW_LOC + 1024 + 64 * x]) == gen) { __builtin_amdgcn_s_sleep(1); if (++sp > (1u << 22)) break; } }
        __builtin_amdgcn_fence(__ATOMIC_ACQUIRE, "agent");
        asm volatile("s_waitcnt vmcnt(0)" ::: "memory");
    }
    __syncthreads();
}
__device__ __forceinline__ void xcc_mode_setup(unsigned char* ldsp) {
    volatile LAS unsigned* MI = (volatile LAS unsigned*)((LAS unsigned char*)ldsp + MISC_OFF);
    if (threadIdx.x == 0) {
        unsigned* bar = (unsigned*)(kargs_ptr()->ws + WS_CTL) + CW_BAR; const unsigned x = xb_xcc_id();
        unsigned npop = 0, xl = 0; bool ok = true;
#pragma unroll
        for (unsigned j = 0; j < 16; ++j) { const unsigned c = xb_ld(&bar[XB_XCNT(j)]); if (c) { ++npop; ok = ok && (c == 32u); if (j < x) ++xl; } }
        const unsigned r = MI[13]; ok = ok && npop == 8u && gridDim.x == 256u && r < 32u;
        MI[10] = ok ? 1u : 0u; MI[11] = 8u * xl + (r & 7u); MI[12] = r >> 3;
    }
    __syncthreads();
}
__global__ void __launch_bounds__(NWAVES * 64, 2) fwd_mega(Args args_unused) {
    extern __shared__ __attribute__((aligned(16))) unsigned char lds[];
    const int wv = __builtin_amdgcn_readfirstlane((int)threadIdx.x >> 6);
    for (int u = threadIdx.x; u < (LDS_BYTES - LDSCTL_OFF) / 4; u += NWAVES * 64) ((LAS unsigned*)((LAS unsigned char*)lds + LDSCTL_OFF))[u] = 0u;
    if (blockIdx.x == 0) { GAS v4u* z = (GAS v4u*)(kargs_ptr()->ws + WS_CTL); for (int u = threadIdx.x; u < 65536 / 16; u += NWAVES * 64) z[u] = (v4u){0u, 0u, 0u, 0u}; }
    asm volatile("s_waitcnt vmcnt(0)" ::: "memory");
    __syncthreads();
    cg::this_grid().sync();
    if (threadIdx.x == 0) { unsigned* bar_ = (unsigned*)(kargs_ptr()->ws + WS_CTL) + CW_BAR; ((volatile LAS unsigned*)((LAS unsigned char*)lds + MISC_OFF))[13] = xb_add(&bar_[XB_XCNT(xb_xcc_id())], 1u); }
#define GRID_BAR() grid_bar(lds)
    p0_prologue(lds, wv);      GRID_BAR();  xcc_mode_setup(lds);
    p1_inproj(lds, wv);        GRID_BAR();
    p2_pre(lds, wv); p2_attention(lds, wv);     GRID_BAR();
    p3_combine(lds, wv);       if (((volatile LAS unsigned*)((LAS unsigned char*)lds + MISC_OFF))[10] != 0u) xcc_bar(lds); else GRID_BAR();
    const bool xmode = ((volatile LAS unsigned*)((LAS unsigned char*)lds + MISC_OFF))[10] != 0u;
    const bool late_ple = xmode && ((((volatile LAS unsigned*)((LAS unsigned char*)lds + MISC_OFF))[11] >> 3) & 1u) != 0u;
    if (!late_ple) p4a_ple(lds, wv);
    p4b_branches(lds, wv);     if (xmode) xcc_bar(lds); else GRID_BAR();
    p5_out(lds, wv);           if (xmode) xcc_bar(lds); else GRID_BAR();
    if (late_ple) p4a_ple(lds, wv);
    p6_ple(lds, wv);
    if (gridDim.x != 256) { GRID_BAR(); p7_final(lds, wv); }
}

extern "C" void kernel_launch(void* const* d_in, const int* in_sizes, int n_in, void* d_out, int out_size, void* d_ws, size_t ws_size, hipStream_t stream) {
    static int grid = 0;
    if (grid == 0) {
        if (n_in != 15 || in_sizes[0] != M * D || out_size != M * D || ws_size < WS_END) { fprintf(stderr, "kernel_launch: unexpected shapes (n_in %d, in0 %d, out %d, ws %zu)\n", n_in, n_in > 0 ? in_sizes[0] : -1, out_size, ws_size); grid = -1; return; }
        int dev = 0, cus = 0, per_cu = 0;
        if (hipGetDevice(&dev) != hipSuccess || hipDeviceGetAttribute(&cus, hipDeviceAttributeMultiprocessorCount, dev) != hipSuccess) { grid = -1; return; }
        if (hipFuncSetAttribute((const void*)fwd_mega, hipFuncAttributeMaxDynamicSharedMemorySize, LDS_BYTES) != hipSuccess) { fprintf(stderr, "kernel_launch: hipFuncSetAttribute failed\n"); grid = -1; return; }
        if (hipOccupancyMaxActiveBlocksPerMultiprocessor(&per_cu, (const void*)fwd_mega, NWAVES * 64, LDS_BYTES) != hipSuccess || per_cu < 1) { fprintf(stderr, "kernel_launch: occupancy query says %d\n", per_cu); per_cu = 1; }
        (void)hipGetLastError();
        grid = cus * per_cu;
    }
    if (grid < 0) return;
    Args a{};
    for (int i = 0; i < 15; ++i) a.in[i] = (const float*)d_in[i];
    a.out = (float*)d_out; a.ws = (unsigned char*)d_ws;
    void* kargs[] = {&a};
    hipError_t e = hipLaunchCooperativeKernel((const void*)fwd_mega, dim3(grid), dim3(NWAVES * 64), kargs, LDS_BYTES, stream);
    if (e != hipSuccess) fprintf(stderr, "cooperative launch failed: %s (grid %d)\n", hipGetErrorString(e), grid);
}
```

```cpp
#include <hip/hip_runtime.h>
#include <hip/hip_cooperative_groups.h>
#include <cstdio>
#include <cstdint>
namespace cg = cooperative_groups;
template <int K> __device__ __forceinline__ float swz_xor(float v) { return __int_as_float(__builtin_amdgcn_ds_swizzle(__float_as_int(v), 0x1f | (K << 10))); }
__device__ __forceinline__ float half_sum(float v) { auto rr = __builtin_amdgcn_permlane32_swap(__float_as_uint(v), __float_as_uint(v), false, false); return __uint_as_float(rr[0]) + __uint_as_float(rr[1]); }
__device__ __forceinline__ int lane_id_opaque() { unsigned m = ~0u; asm volatile("" : "+s"(m)); return (int)__builtin_amdgcn_mbcnt_hi(m, __builtin_amdgcn_mbcnt_lo(m, 0u)); }
namespace pg8 {
#define PG8_LAS __attribute__((address_space(3)))
typedef unsigned short bf16_t;
typedef short bf16x8 __attribute__((ext_vector_type(8)));
typedef float f32x4 __attribute__((ext_vector_type(4)));
typedef unsigned u32x4 __attribute__((ext_vector_type(4)));
constexpr int BM = 256, BK = 64, HALF = 128, HTB = HALF * BK * 2  , STAGE_BYTES = 8 * HTB, NXCD = 8, WGM = 8;

__host__ __device__ __forceinline__ int lds_byte(int r, int c) { const int st = (r >> 4) * 2 + (c >> 5), rr = r & 15, cc = c & 31, ob = rr * 64 + cc * 2; return st * 1024 + (ob ^ (((ob >> 9) & 1) << 5)); }
__host__ __device__ __forceinline__ void stage_rc(int b, int& R, int& C) { const int st = b / 1024, sb = b % 1024, swz = sb ^ (((sb >> 9) & 1) << 5); R = (st >> 1) * 16 + swz / 64; C = (st & 1) * 32 + (swz % 64) / 2; }
__host__ __device__ __forceinline__ int perm32(int rho) { const int n = rho >> 4, i = rho & 15; return 8 * (i >> 2) + 4 * n + (i & 3); }

struct Unit { int pm, pn, g; };
struct Gemm { const bf16_t* A0; const bf16_t* B0t; const bf16_t* A1; const bf16_t* B1t; int M, N, K; };

struct StaticOrder {
    int nM, nN, nwg, G, c, fx, fpm, fpn;
    __host__ __device__ void init(int M, int N, int G_, int c_) { nM = M / BM; nN = N / BM; nwg = nM * nN; G = G_; c = c_; fx = 0; fpm = 0; fpn = 0; }
    __host__ __device__ void fix(int pm, int pn) { fx = 1; fpm = pm; fpn = pn; }
    __host__ __device__ bool next(int i, Unit& u) const {
        if (fx) { if (i >= 1) return false; u.pm = fpm; u.pn = fpn; u.g = 0; return true; }
        const long L = (long)i * G + c; if (L >= nwg) return false;
        int wgid = (int)L; { const int q = nwg / NXCD, r = nwg % NXCD, xcd = wgid % NXCD, off = wgid / NXCD; wgid = (xcd < r ? xcd * (q + 1) : r * (q + 1) + (xcd - r) * q) + off; }
        const int nig = WGM * nN, gid = wgid / nig, fm = gid * WGM, gsz = (nM - fm) < WGM ? (nM - fm) : WGM;
        u.pm = fm + ((wgid % nig) % gsz); u.pn = (wgid % nig) / gsz; u.g = 0; return true;
    }
    __device__ __forceinline__ void a_ready(const Unit&) const {}
    __device__ __forceinline__ void done(const Unit&) const {}
};

__device__ __forceinline__ unsigned cvt_pk_bf16(float lo, float hi) { unsigned r; asm volatile("v_cvt_pk_bf16_f32 %0, %1, %2" : "=v"(r) : "v"(lo), "v"(hi)); return r; }
__device__ __forceinline__ float bf_lo(unsigned w) { return __uint_as_float(w << 16); }
__device__ __forceinline__ float bf_hi(unsigned w) { return __uint_as_float(w & 0xffff0000u); }
__device__ __forceinline__ float sigmoid_f(float v) { return __builtin_amdgcn_rcpf(1.0f + __expf(-v)); }
__device__ __forceinline__ f32x4 sigmoid4(f32x4 v) { return (f32x4){sigmoid_f(v[0]), sigmoid_f(v[1]), sigmoid_f(v[2]), sigmoid_f(v[3])}; }
typedef unsigned u32x2 __attribute__((ext_vector_type(2)));

struct EpiInProj {
    static constexpr bool PERM = true, AFTER_DRAIN = false, CHAIN = false;
    unsigned char* seg0;
    unsigned char* gseg0;
    const float* rope;
    float* kmean;
    float qscale;
    __device__ __forceinline__ void operator()(f32x4 (&acc)[2][2][4][2], const Unit& u, int wr, int wc, int fr, int fq) const {
        const int pn = u.pn; bf16_t* base; int ldc, colt, mode; float sc = 1.f;
        if (pn < 16) { const int seg = pn >> 1; base = (bf16_t*)(seg0 + (size_t)seg * (16u << 20)); ldc = 512; colt = (pn & 1) * 256;
            mode = (seg == 0 || seg == 1 || seg == 4 || seg == 5) ? 1 : ((seg == 3 || seg == 7) ? 2 : 0); if (seg == 0 || seg == 4) sc = qscale; }
        else { base = (bf16_t*)(gseg0 + (size_t)((pn - 16) >> 2) * (32u << 20)); ldc = 1024; colt = ((pn - 16) & 3) * 256; mode = 3; }
        const int row0 = u.pm * BM + wr * 64 + fr, col0 = colt + wc * 32 + 8 * fq;
        if (mode == 1 && (wc & 1) == 0) {
            const float sgn = (fq == 0) ? -1.f : ((fq == 1) ? 1.f : 0.f); const bool rot = fq < 2;
#pragma unroll
            for (int ai = 0; ai < 2; ++ai)
#pragma unroll
                for (int m = 0; m < 4; ++m) { const int t = (row0 + ai * HALF + m * 16) & 8191; const f32x4* tp = (const f32x4*)(rope + (size_t)t * 16);
                    f32x4 cs[2], sn[2]; cs[0] = tp[0]; cs[1] = tp[1]; sn[0] = tp[2]; sn[1] = tp[3];
#pragma unroll
                    for (int bj = 0; bj < 2; ++bj)
#pragma unroll
                        for (int n = 0; n < 2; ++n) { f32x4 v = acc[ai][bj][m][n], p;
                            p[0] = swz_xor<16>(v[0]); p[1] = swz_xor<16>(v[1]); p[2] = swz_xor<16>(v[2]); p[3] = swz_xor<16>(v[3]);
                            const f32x4 o = v * cs[n] + (p * sn[n]) * sgn; acc[ai][bj][m][n] = rot ? o : v; } }
        }
        if (pn == 10 || pn == 11) {
            const int b = u.pm >> 5, nblk = u.pm & 31;
#pragma unroll
            for (int bj = 0; bj < 2; ++bj)
#pragma unroll
                for (int n = 0; n < 2; ++n) { f32x4 s = (f32x4){0.f, 0.f, 0.f, 0.f};
#pragma unroll
                    for (int ai = 0; ai < 2; ++ai)
#pragma unroll
                        for (int m = 0; m < 4; ++m) s += acc[ai][bj][m][n];
#pragma unroll
                    for (int j = 0; j < 4; ++j) { float x = s[j]; x += swz_xor<1>(x); x += swz_xor<2>(x); x += swz_xor<4>(x); x += swz_xor<8>(x);
                        if (fr == 0) { const int cg_ = (pn - 10) * 256 + bj * HALF + wc * 32 + 8 * fq + 4 * n + j; atomicAdd(kmean + ((size_t)((b * 8 + (cg_ >> 6)) * 32 + nblk)) * 64 + (cg_ & 63), x * (1.0f / 256.0f)); } } }
        }
#pragma unroll
        for (int ai = 0; ai < 2; ++ai)
#pragma unroll
            for (int m = 0; m < 4; ++m) { bf16_t* rowp = base + (size_t)(row0 + ai * HALF + m * 16) * ldc + col0;
#pragma unroll
                for (int bj = 0; bj < 2; ++bj) { f32x4 v0 = acc[ai][bj][m][0], v1 = acc[ai][bj][m][1];
                    if (mode == 2) { v0 = v0 * sigmoid4(v0); v1 = v1 * sigmoid4(v1); }
                    else if (mode == 3) { v0 = sigmoid4(v0); v1 = sigmoid4(v1); }
                    v0 = v0 * sc; v1 = v1 * sc; u32x4 w; w.x = cvt_pk_bf16(v0[0], v0[1]); w.y = cvt_pk_bf16(v0[2], v0[3]); w.z = cvt_pk_bf16(v1[0], v1[1]); w.w = cvt_pk_bf16(v1[2], v1[3]);
                    if (mode >= 2) __builtin_nontemporal_store(w, (u32x4*)(rowp + bj * HALF)); else *(u32x4*)(rowp + bj * HALF) = w; } }
    }
};
struct EpiStore {
    static constexpr bool PERM = true, AFTER_DRAIN = false, CHAIN = false;
    bf16_t* O; int ldc; int tstride;
    __device__ __forceinline__ void operator()(f32x4 (&acc)[2][2][4][2], const Unit& u, int wr, int wc, int fr, int fq) const {
        const int row0 = u.pm * BM + wr * 64 + fr, col0 = u.pn * tstride + wc * 32 + 8 * fq;
#pragma unroll
        for (int ai = 0; ai < 2; ++ai)
#pragma unroll
            for (int m = 0; m < 4; ++m) { bf16_t* rowp = O + (size_t)(row0 + ai * HALF + m * 16) * ldc + col0;
#pragma unroll
                for (int bj = 0; bj < 2; ++bj) { const f32x4 v0 = acc[ai][bj][m][0], v1 = acc[ai][bj][m][1];
                    u32x4 w; w.x = cvt_pk_bf16(v0[0], v0[1]); w.y = cvt_pk_bf16(v0[2], v0[3]); w.z = cvt_pk_bf16(v1[0], v1[1]); w.w = cvt_pk_bf16(v1[2], v1[3]);
                    *(u32x4*)(rowp + bj * HALF) = w; } }
    }
};
struct EpiMerge {
    static constexpr bool PERM = true, AFTER_DRAIN = false, CHAIN = true;
    const bf16_t* SA; const bf16_t* SB; bf16_t* O;
    __device__ __forceinline__ void operator()(f32x4 (&acc)[2][2][4][2], const Unit& u, int wr, int wc, int fr, int fq) const {
        const int row0 = u.pm * BM + wr * 64 + fr, col0 = u.pn * BM + wc * 32 + 8 * fq;
#pragma unroll
        for (int ai = 0; ai < 2; ++ai)
#pragma unroll
            for (int m = 0; m < 4; ++m) { const size_t off = (size_t)(row0 + ai * HALF + m * 16) * 1024 + col0;
#pragma unroll
                for (int bj = 0; bj < 2; ++bj) { const u32x4 b = *(const u32x4*)(SB + off + bj * HALF);
                    const f32x4 b0 = (f32x4){bf_lo(b.x), bf_hi(b.x), bf_lo(b.y), bf_hi(b.y)}, b1 = (f32x4){bf_lo(b.z), bf_hi(b.z), bf_lo(b.w), bf_hi(b.w)};
                    if (u.g == 0) { const u32x4 a = *(const u32x4*)(SA + off + bj * HALF);
                        const f32x4 a0 = (f32x4){bf_lo(a.x), bf_hi(a.x), bf_lo(a.y), bf_hi(a.y)}, a1 = (f32x4){bf_lo(a.z), bf_hi(a.z), bf_lo(a.w), bf_hi(a.w)};
                        f32x4 r0, r1;
#pragma unroll
                        for (int j = 0; j < 4; ++j) { r0[j] = a0[j] * __builtin_amdgcn_rcpf(b0[j]); r1[j] = a1[j] * __builtin_amdgcn_rcpf(b1[j]); }
                        acc[ai][bj][m][0] *= r0; acc[ai][bj][m][1] *= r1; }
                    else { const f32x4 v0 = acc[ai][bj][m][0] * b0, v1 = acc[ai][bj][m][1] * b1;
                        u32x4 w; w.x = cvt_pk_bf16(v0[0], v0[1]); w.y = cvt_pk_bf16(v0[2], v0[3]); w.z = cvt_pk_bf16(v1[0], v1[1]); w.w = cvt_pk_bf16(v1[2], v1[3]);
                        *(u32x4*)(O + off + bj * HALF) = w; } }
                asm volatile("" ::: "memory"); }
    }
};
template <bool WRITE_F32> struct EpiResid {
    static constexpr bool PERM = false, AFTER_DRAIN = false, CHAIN = false;
    const float* X; float* out; bf16_t* xb;
    __device__ __forceinline__ void operator()(f32x4 (&acc)[2][2][4][2], const Unit& u, int wr, int wc, int fr, int fq) const {
        const int col0 = u.pn * BM + wc * 32 + 4 * fq;
#pragma unroll
        for (int ai = 0; ai < 2; ++ai)
#pragma unroll
            for (int m = 0; m < 4; ++m) { const size_t off = (size_t)(u.pm * BM + ai * HALF + wr * 64 + m * 16 + fr) * 1024 + col0;
#pragma unroll
                for (int bj = 0; bj < 2; ++bj)
#pragma unroll
                    for (int n = 0; n < 2; ++n) { const size_t o2 = off + bj * HALF + n * 16; const f32x4 v = __builtin_nontemporal_load((const f32x4*)(X + o2)) + acc[ai][bj][m][n];
                        if (WRITE_F32) *(f32x4*)(out + o2) = v; u32x2 w; w.x = cvt_pk_bf16(v[0], v[1]); w.y = cvt_pk_bf16(v[2], v[3]); *(u32x2*)(xb + o2) = w; } }
    }
};
struct EpiPle {
    static constexpr bool PERM = false, AFTER_DRAIN = false, CHAIN = false;
    float* out; const bf16_t* ple;
    __device__ __forceinline__ void operator()(f32x4 (&acc)[2][2][4][2], const Unit& u, int wr, int wc, int fr, int fq) const {
        const int col0 = u.pn * BM + wc * 32 + 4 * fq;
#pragma unroll
        for (int ai = 0; ai < 2; ++ai)
#pragma unroll
            for (int m = 0; m < 4; ++m) { const size_t off = (size_t)(u.pm * BM + ai * HALF + wr * 64 + m * 16 + fr) * 1024 + col0;
#pragma unroll
                for (int bj = 0; bj < 2; ++bj)
#pragma unroll
                    for (int n = 0; n < 2; ++n) { const size_t o2 = off + bj * HALF + n * 16; const u32x2 pw = __builtin_nontemporal_load((const u32x2*)(ple + o2));
                        const f32x4 pl = (f32x4){bf_lo(pw.x), bf_hi(pw.x), bf_lo(pw.y), bf_hi(pw.y)};
                        const f32x4 v = *(const f32x4*)(out + o2) + sigmoid4(acc[ai][bj][m][n]) * pl; *(f32x4*)(out + o2) = v; } }
    }
};
struct EpiPleNorm {
    static constexpr bool PERM = false, AFTER_DRAIN = true, CHAIN = false;
    float* out; const bf16_t* x1b; const bf16_t* ple; const float* fg; float* xbuf; unsigned* cnt;
    __device__ __forceinline__ void operator()(f32x4 (&acc)[2][2][4][2], const Unit& u, int wr, int wc, int fr, int fq) const {}
    __device__ __forceinline__ void fused(f32x4 (&acc)[2][2][4][2], const Unit& u, int wr, int wc, int fr, int fq, PG8_LAS unsigned char* lds, int wid, int lane) const {
        PG8_LAS float* P = (PG8_LAS float*)lds;
        PG8_LAS float* S = (PG8_LAS float*)(lds + 4096);
        const int col0 = u.pn * BM + wc * 32 + 4 * fq;
#pragma unroll
        for (int ai = 0; ai < 2; ++ai)
#pragma unroll
            for (int m = 0; m < 4; ++m) { const size_t off = (size_t)(u.pm * BM + ai * HALF + wr * 64 + m * 16 + fr) * 1024 + col0;
#pragma unroll
                for (int bj = 0; bj < 2; ++bj)
#pragma unroll
                    for (int n = 0; n < 2; ++n) { const size_t o2 = off + bj * HALF + n * 16; const u32x2 pw = __builtin_nontemporal_load((const u32x2*)(ple + o2 + (off - col0) + u.pn * BM));
                        const f32x4 pl = (f32x4){bf_lo(pw.x), bf_hi(pw.x), bf_lo(pw.y), bf_hi(pw.y)};
                        const u32x2 xw = *(const u32x2*)(x1b + o2); const f32x4 x1 = (f32x4){bf_lo(xw.x), bf_hi(xw.x), bf_lo(xw.y), bf_hi(xw.y)};
                        acc[ai][bj][m][n] = x1 + sigmoid4(acc[ai][bj][m][n]) * pl; }
                asm volatile("" : "+v"(acc[ai][0][m][0]), "+v"(acc[ai][0][m][1]), "+v"(acc[ai][1][m][0]), "+v"(acc[ai][1][m][1]));
                if (m & 1) asm volatile("" ::: "memory"); }
#pragma unroll
        for (int ai = 0; ai < 2; ++ai)
#pragma unroll
            for (int m = 0; m < 4; ++m) { float s = 0.f;
#pragma unroll
                for (int bj = 0; bj < 2; ++bj)
#pragma unroll
                    for (int n = 0; n < 2; ++n) { const f32x4 x = acc[ai][bj][m][n]; s += (x[0] * x[0] + x[1] * x[1]) + (x[2] * x[2] + x[3] * x[3]); }
                s += swz_xor<16>(s); s = half_sum(s);
                if (fq == 0) P[(ai * HALF + wr * 64 + m * 16 + fr) * 4 + wc] = s; }
        asm volatile("s_waitcnt lgkmcnt(0)" ::: "memory"); __builtin_amdgcn_s_barrier(); asm volatile("" ::: "memory");
        const int row = wid * 32 + (lane & 31);
        if (lane < 32) { const float t = (P[row * 4 + 0] + P[row * 4 + 1]) + (P[row * 4 + 2] + P[row * 4 + 3]);
            __hip_atomic_store(xbuf + (size_t)(u.pm * BM + row) * 4 + u.pn, t, __ATOMIC_RELAXED, __HIP_MEMORY_SCOPE_AGENT); }
        asm volatile("s_waitcnt vmcnt(0)" ::: "memory");
        if (lane == 0) __hip_atomic_fetch_add(cnt + 64 * u.pm, 1u, __ATOMIC_RELAXED, __HIP_MEMORY_SCOPE_AGENT);
        if (wid == 0) { unsigned sp = 0;
            while ((unsigned)__builtin_amdgcn_readfirstlane(__hip_atomic_load(cnt + 64 * u.pm, __ATOMIC_RELAXED, __HIP_MEMORY_SCOPE_AGENT)) < 32u) { __builtin_amdgcn_s_sleep(2); if (++sp > (1u << 22)) break; }
            __builtin_amdgcn_fence(__ATOMIC_ACQUIRE, "agent"); }
        asm volatile("s_waitcnt vmcnt(0) lgkmcnt(0)" ::: "memory"); __builtin_amdgcn_s_barrier(); asm volatile("" ::: "memory");
        if (lane < 32) { const float* slot = xbuf + (size_t)(u.pm * BM + row) * 4; float q = 0.f;
#pragma unroll
            for (int t = 0; t < 4; ++t) q += __hip_atomic_load(slot + t, __ATOMIC_RELAXED, __HIP_MEMORY_SCOPE_AGENT);
            S[row] = 1.0f / sqrtf(q * (1.0f / 1024.0f) + 1e-6f); }
        asm volatile("s_waitcnt lgkmcnt(0)" ::: "memory"); __builtin_amdgcn_s_barrier(); asm volatile("" ::: "memory");
        f32x4 gv[2][2];
#pragma unroll
        for (int bj = 0; bj < 2; ++bj)
#pragma unroll
            for (int n = 0; n < 2; ++n) gv[bj][n] = *(const f32x4*)(fg + col0 + bj * HALF + n * 16);
#pragma unroll
        for (int ai = 0; ai < 2; ++ai)
#pragma unroll
            for (int m = 0; m < 4; ++m) { const int r = ai * HALF + wr * 64 + m * 16 + fr; const float rs = S[r]; const size_t off = (size_t)(u.pm * BM + r) * 1024 + col0;
#pragma unroll
                for (int bj = 0; bj < 2; ++bj)
#pragma unroll
                    for (int n = 0; n < 2; ++n) __builtin_nontemporal_store(acc[ai][bj][m][n] * rs * gv[bj][n], (f32x4*)(out + off + bj * HALF + n * 16)); }
    }
};
struct PairOrder {
    StaticOrder s;
    __host__ __device__ void init(int M, int N, int G_, int c_) { s.init(M, N, G_, c_); }
    __host__ __device__ bool next(int i, Unit& u) const { if (!s.next(i >> 1, u)) return false; u.g = i & 1; return true; }
    __device__ __forceinline__ void a_ready(const Unit&) const {}
    __device__ __forceinline__ void done(const Unit&) const {}
};
template <class Epi, class Sched, bool ALIGN_EPI = false, bool SP2 = false>
__device__ __forceinline__ void gemm_phase(PG8_LAS unsigned char* lds, const Gemm g, const Sched& S, const Epi& E, int wv_) {
    int tid_ = wv_ * 64 + lane_id_opaque(); asm volatile("" : "+v"(tid_));
    const int tid = tid_, wid = __builtin_amdgcn_readfirstlane(tid >> 6), lane = tid & 63, wr = wid >> 2, wc = wid & 3, fr = lane & 15, fq = lane >> 4;
    const int K = g.K, nt = K / BK;
    unsigned voffA[2], voffB[2];
#pragma unroll
    for (int i = 0; i < 2; ++i) { int R, C; stage_rc(tid * 16 + i * 8192, R, C); const int Rb = Epi::PERM ? ((R & ~31) + perm32(R & 31)) : R;
        voffA[i] = (unsigned)(R * K + C) * 2u; voffB[i] = (unsigned)(Rb * K + C) * 2u; }
    const size_t kstep = (size_t)(BK * 2);
    const size_t hstep = (size_t)HALF * K * 2;
    const size_t tstep = 2 * hstep;
    const unsigned ldsw = (unsigned)wid * 1024u;
    const int aoff = lds_byte(wr * 64 + fr, fq * 8), boff = lds_byte(wc * 32 + fr, fq * 8);
#define PG8_SA(b, h) (((b) * 2 + (h)) * HTB)
#define PG8_SB(b, h) ((4 + (b) * 2 + (h)) * HTB)
#define PG8_STAGE(bufoff, gbase, voff) do { _Pragma("unroll") for (int _i = 0; _i < 2; ++_i) \
        __builtin_amdgcn_global_load_lds((const unsigned*)((const char*)(gbase) + (voff)[_i]), (PG8_LAS unsigned*)(lds + (bufoff) + ldsw + _i * 8192), 16, 0, 0); } while (0)
#define PG8_LDA(dst, b, h) do { _Pragma("unroll") for (int m = 0; m < 4; ++m) _Pragma("unroll") for (int k = 0; k < 2; ++k) dst[m][k] = *(const PG8_LAS bf16x8*)(lds + PG8_SA(b, h) + aoff + m * 2048 + k * 1024); } while (0)
#define PG8_LDB(dst, b, h) do { _Pragma("unroll") for (int n = 0; n < 2; ++n) _Pragma("unroll") for (int k = 0; k < 2; ++k) dst[n][k] = *(const PG8_LAS bf16x8*)(lds + PG8_SB(b, h) + boff + n * 2048 + k * 1024); } while (0)
#define PG8_MMA(ai, bj, At, Bt) do { __builtin_amdgcn_s_setprio(1); _Pragma("unroll") for (int m = 0; m < 4; ++m) _Pragma("unroll") for (int n = 0; n < 2; ++n) _Pragma("unroll") for (int k = 0; k < 2; ++k) \
        acc[ai][bj][m][n] = __builtin_amdgcn_mfma_f32_16x16x32_bf16(Bt[n][k], At[m][k], acc[ai][bj][m][n], 0, 0, 0); __builtin_amdgcn_s_setprio(0); } while (0)
#define PG8_WAIT_V(n) asm volatile("s_waitcnt vmcnt(" #n ")" ::: "memory")
#define PG8_WAIT_L(n) asm volatile("s_waitcnt lgkmcnt(" #n ")" ::: "memory")
#define PG8_BAR __builtin_amdgcn_s_barrier()
#define PG8_SCHED __builtin_amdgcn_sched_barrier(0)
    Unit cur, nxt; int ui = 0;
    if (!S.next(0, cur)) return;
    f32x4 acc[2][2][4][2];
#pragma unroll
    for (int a = 0; a < 2; ++a)
#pragma unroll
        for (int b = 0; b < 2; ++b)
#pragma unroll
            for (int m = 0; m < 4; ++m)
#pragma unroll
                for (int n = 0; n < 2; ++n) acc[a][b][m][n] = (f32x4){0.f, 0.f, 0.f, 0.f};
    bf16x8 At[4][2], B0[2][2], B1[2][2];
    const char* cA = (const char*)(cur.g ? g.A1 : g.A0) + (size_t)cur.pm * tstep; const char* cB = (const char*)(cur.g ? g.B1t : g.B0t) + (size_t)cur.pn * tstep;
    S.a_ready(cur);
    if constexpr (SP2) {
        PG8_STAGE(PG8_SB(0, 0), cB, voffB); PG8_STAGE(PG8_SB(0, 1), cB + hstep, voffB); PG8_STAGE(PG8_SA(0, 0), cA, voffA); PG8_STAGE(PG8_SA(0, 1), cA + hstep, voffA);
        if (wr == 1) PG8_BAR;
        PG8_WAIT_V(2); PG8_BAR;
        PG8_STAGE(PG8_SB(1, 0), cB + kstep, voffB); PG8_STAGE(PG8_SA(1, 0), cA + kstep, voffA); PG8_STAGE(PG8_SB(1, 1), cB + hstep + kstep, voffB);
        PG8_WAIT_V(6); PG8_BAR;
    } else {
        PG8_STAGE(PG8_SB(0, 0), cB, voffB); PG8_STAGE(PG8_SA(0, 0), cA, voffA); PG8_STAGE(PG8_SB(0, 1), cB + hstep, voffB); PG8_STAGE(PG8_SA(0, 1), cA + hstep, voffA);
        if (wr == 1) PG8_BAR;
        PG8_WAIT_V(4); PG8_BAR;
        PG8_STAGE(PG8_SB(1, 0), cB + kstep, voffB); PG8_STAGE(PG8_SA(1, 0), cA + kstep, voffA); PG8_STAGE(PG8_SB(1, 1), cB + hstep + kstep, voffB);
        PG8_WAIT_V(6); PG8_BAR;
    }
    for (;;) {
        const bool has_next = S.next(ui + 1, nxt);
        const char* nA = has_next ? (const char*)(nxt.g ? g.A1 : g.A0) + (size_t)nxt.pm * tstep : cA; const char* nB = has_next ? (const char*)(nxt.g ? g.B1t : g.B0t) + (size_t)nxt.pn * tstep : cB;
        for (int t = 0; t < nt; t += 2) {
            const bool last = (t == nt - 2);
            const char* a1 = cA + (size_t)(t + 1) * kstep;
            const char* a2 = last ? nA : cA + (size_t)(t + 2) * kstep; const char* b2 = last ? nB : cB + (size_t)(t + 2) * kstep;
            const char* a3 = a2 + kstep; const char* b3 = b2 + kstep;
            if (last && has_next) S.a_ready(nxt);
            if constexpr (SP2) {
            PG8_LDB(B0, 0, 0); PG8_LDB(B1, 0, 1); PG8_SCHED; PG8_LDA(At, 0, 0); PG8_STAGE(PG8_SA(1, 1), a1 + hstep, voffA);
            PG8_WAIT_V(8); PG8_WAIT_L(0); PG8_BAR; PG8_MMA(0, 0, At, B0); PG8_MMA(0, 1, At, B1); PG8_BAR; PG8_SCHED;
            PG8_LDA(At, 0, 1); PG8_STAGE(PG8_SB(0, 0), b2, voffB); PG8_STAGE(PG8_SB(0, 1), b2 + hstep, voffB); PG8_STAGE(PG8_SA(0, 0), a2, voffA);
            PG8_WAIT_V(8); PG8_WAIT_L(0); PG8_BAR; PG8_MMA(1, 0, At, B0); PG8_MMA(1, 1, At, B1); PG8_BAR; PG8_SCHED;
            PG8_LDB(B0, 1, 0); PG8_LDB(B1, 1, 1); PG8_SCHED; PG8_LDA(At, 1, 0); PG8_STAGE(PG8_SA(0, 1), a2 + hstep, voffA);
            PG8_WAIT_V(8); PG8_WAIT_L(0); PG8_BAR; PG8_MMA(0, 0, At, B0); PG8_MMA(0, 1, At, B1); PG8_BAR; PG8_SCHED;
            PG8_LDA(At, 1, 1); PG8_STAGE(PG8_SB(1, 0), b3, voffB); PG8_STAGE(PG8_SB(1, 1), b3 + hstep, voffB); PG8_STAGE(PG8_SA(1, 0), a3, voffA);
            PG8_WAIT_V(8); PG8_WAIT_L(0); PG8_BAR; PG8_MMA(1, 0, At, B0); PG8_MMA(1, 1, At, B1); PG8_BAR; PG8_SCHED;
            } else {
            PG8_LDB(B0, 0, 0); PG8_SCHED; PG8_LDA(At, 0, 0); PG8_STAGE(PG8_SA(1, 1), a1 + hstep, voffA);
            PG8_WAIT_L(8); PG8_BAR; PG8_WAIT_L(0); PG8_MMA(0, 0, At, B0); PG8_BAR; PG8_SCHED;
            PG8_LDB(B1, 0, 1); PG8_STAGE(PG8_SB(0, 0), b2, voffB);
            PG8_BAR; PG8_WAIT_L(0); PG8_MMA(0, 1, At, B1); PG8_BAR;
            PG8_LDA(At, 0, 1); PG8_STAGE(PG8_SA(0, 0), a2, voffA);
            PG8_BAR; PG8_WAIT_L(0); PG8_MMA(1, 0, At, B0); PG8_BAR; PG8_SCHED;
            PG8_STAGE(PG8_SB(0, 1), b2 + hstep, voffB);
            PG8_WAIT_V(6); PG8_BAR; PG8_MMA(1, 1, At, B1); PG8_BAR;
            PG8_LDB(B0, 1, 0); PG8_SCHED; PG8_LDA(At, 1, 0); PG8_STAGE(PG8_SA(0, 1), a2 + hstep, voffA);
            PG8_WAIT_L(8); PG8_BAR; PG8_WAIT_L(0); PG8_MMA(0, 0, At, B0); PG8_BAR; PG8_SCHED;
            PG8_LDB(B1, 1, 1); PG8_STAGE(PG8_SB(1, 0), b3, voffB);
            PG8_BAR; PG8_WAIT_L(0); PG8_MMA(0, 1, At, B1); PG8_BAR;
            PG8_LDA(At, 1, 1); PG8_STAGE(PG8_SA(1, 0), a3, voffA);
            PG8_BAR; PG8_WAIT_L(0); PG8_MMA(1, 0, At, B0); PG8_BAR; PG8_SCHED;
            PG8_STAGE(PG8_SB(1, 1), b3 + hstep, voffB);
            PG8_WAIT_V(6); PG8_BAR; PG8_MMA(1, 1, At, B1); PG8_BAR;
            }
        }
        if constexpr (ALIGN_EPI) { if (wr == 0) PG8_BAR; }
        if constexpr (!Epi::AFTER_DRAIN) { E(acc, cur, wr, wc, fr, fq); S.done(cur); }
        if (!has_next) break;
        if (!(Epi::CHAIN && cur.g == 0)) {
#pragma unroll
        for (int a = 0; a < 2; ++a)
#pragma unroll
            for (int b = 0; b < 2; ++b)
#pragma unroll
                for (int m = 0; m < 4; ++m)
#pragma unroll
                    for (int n = 0; n < 2; ++n) acc[a][b][m][n] = (f32x4){0.f, 0.f, 0.f, 0.f};
        }
        cur = nxt; cA = nA; cB = nB; ++ui;
        if constexpr (ALIGN_EPI) { if (wr == 1) PG8_BAR; }
    }
    PG8_WAIT_V(0);
    if constexpr (!ALIGN_EPI) { if (wr == 0) PG8_BAR; }
    PG8_BAR;
    if constexpr (Epi::AFTER_DRAIN) { E.fused(acc, cur, wr, wc, fr, fq, lds, wid, lane); S.done(cur); }
#undef PG8_SA
#undef PG8_SB
#undef PG8_STAGE
#undef PG8_LDA
#undef PG8_LDB
#undef PG8_MMA
#undef PG8_WAIT_V
#undef PG8_WAIT_L
#undef PG8_BAR
#undef PG8_SCHED
}
}
#include <hip/hip_bf16.h>
#include <cmath>
namespace attn_body {
using bf16=__hip_bfloat16;
using bf16x8=__attribute__((ext_vector_type(8)))short;
using s16x4=__attribute__((ext_vector_type(4)))short;
using f32x16=__attribute__((ext_vector_type(16)))float;
using u32x4=__attribute__((ext_vector_type(4)))unsigned;
using f32x4_t=__attribute__((ext_vector_type(4)))float;
constexpr int BATCH=2,SEQ=8192,D=64,DM=512;
constexpr int NW=8,QBLK=32,QB=QBLK*NW,KVBLK=64,NQB=SEQ/QB;
constexpr int ATTN_PITCH=DM, ATTN_UNIT_ROWS=QB;
__device__ __forceinline__ int crow(int r,int hi){return (r&3)+8*(r>>2)+4*hi;}
#define SBAR() __builtin_amdgcn_sched_barrier(0)
__device__ __forceinline__ void cmask(f32x16&p0,f32x16&p1,int jb,int qrel,int hi){
  const float NEG=-INFINITY; int kb=64*jb+4*hi;
  #pragma unroll
  for(int r=0;r<16;++r){int kv=kb+(r&3)+8*(r>>2); if(kv>qrel)p0[r]=NEG; if(kv+32>qrel)p1[r]=NEG;}
}

constexpr int NSLOT=3, SLOTB=8192;
constexpr int LDS_K=0, LDS_V=NSLOT*SLOTB, LDS_V2=2*NSLOT*SLOTB, LDS_WS=3*NSLOT*SLOTB, LDS_OST=LDS_WS+NW*64*4, LDS_BYTES=LDS_OST+NW*4096;
constexpr float C2=0.125f*1.4426950408889634f;
__device__ __forceinline__ void glds16(const void*gsrc,unsigned lds_dst){unsigned keep;
  asm volatile("s_mov_b32 %0, m0\n\ts_mov_b32 m0, %2\n\ts_nop 0\n\tglobal_load_lds_dwordx4 %1, off\n\ts_mov_b32 m0, %0":"=&s"(keep):"v"(gsrc),"s"(lds_dst):"memory");}
__device__ __forceinline__ float max3f(float a,float b,float c){float r;asm("v_max3_f32 %0, %1, %2, %3":"=v"(r):"v"(a),"v"(b),"v"(c));return r;}
__device__ __forceinline__ float max2f(float a,float b){float r;asm("v_max_f32_e32 %0, %1, %2":"=v"(r):"v"(a),"v"(b));return r;}
__device__ __forceinline__ float fadd_s(float a,float b){float r;asm("v_add_f32_e32 %0, %1, %2":"=v"(r):"v"(a),"v"(b));return r;}
__device__ __forceinline__ float fsub_s(float a,float b){float r;asm("v_sub_f32_e32 %0, %1, %2":"=v"(r):"v"(a),"v"(b));return r;}
typedef float f32x2_t __attribute__((ext_vector_type(2))); typedef __bf16 bf16x2_t __attribute__((ext_vector_type(2)));
__device__ __forceinline__ unsigned cvtpk_s(float lo,float hi){f32x2_t v={lo,hi};bf16x2_t b=__builtin_convertvector(v,bf16x2_t);return __builtin_bit_cast(unsigned,b);}
#define WAIT_BAR(N) asm volatile("s_waitcnt vmcnt(" #N ") lgkmcnt(0)\n\ts_barrier":::"memory")

__device__ __forceinline__ void qkt(f32x16&p0,f32x16&p1,const char*Kslot,const bf16x8*qr,const f32x16&negm,int r32,int hi){
  const char*kb=Kslot+hi*1024+r32*16;
  #pragma unroll
  for(int d0=0;d0<4;++d0){
    const bf16x8 b0=*reinterpret_cast<const bf16x8*>(kb+d0*2048);
    const bf16x8 b1=*reinterpret_cast<const bf16x8*>(kb+d0*2048+512);
    if(d0==0){p0=__builtin_amdgcn_mfma_f32_32x32x16_bf16(b0,qr[0],negm,0,0,0);p1=__builtin_amdgcn_mfma_f32_32x32x16_bf16(b1,qr[0],negm,0,0,0);}
    else{p0=__builtin_amdgcn_mfma_f32_32x32x16_bf16(b0,qr[d0],p0,0,0,0);p1=__builtin_amdgcn_mfma_f32_32x32x16_bf16(b1,qr[d0],p1,0,0,0);}}
}
typedef __attribute__((address_space(3))) const char* lds_cptr;
typedef short v4i16_t __attribute__((ext_vector_type(4)));
__device__ __forceinline__ void kload8(bf16x8*kf,lds_cptr kp){
  kf[0]=*(const __attribute__((address_space(3))) bf16x8*)(kp);      kf[1]=*(const __attribute__((address_space(3))) bf16x8*)(kp+512);
  kf[2]=*(const __attribute__((address_space(3))) bf16x8*)(kp+2048); kf[3]=*(const __attribute__((address_space(3))) bf16x8*)(kp+2560);
  kf[4]=*(const __attribute__((address_space(3))) bf16x8*)(kp+4096); kf[5]=*(const __attribute__((address_space(3))) bf16x8*)(kp+4608);
  kf[6]=*(const __attribute__((address_space(3))) bf16x8*)(kp+6144); kf[7]=*(const __attribute__((address_space(3))) bf16x8*)(kp+6656);
}
__device__ __forceinline__ void kload2(bf16x8*kf,lds_cptr kp,int j){ kf[2*j]=*(const __attribute__((address_space(3))) bf16x8*)(kp+j*2048); kf[2*j+1]=*(const __attribute__((address_space(3))) bf16x8*)(kp+j*2048+512); }
__device__ __forceinline__ s16x4 vtr(lds_cptr p){ return __builtin_bit_cast(s16x4,__builtin_amdgcn_ds_read_tr16_b64_v4i16((__attribute__((address_space(3))) v4i16_t*)p)); }
__device__ __forceinline__ float rowmax(const f32x16&p0,const f32x16&p1){
  float a=max3f(p0[0],p0[1],p1[0]),b=max3f(p0[2],p0[3],p1[1]);a=max3f(a,p1[2],p1[3]);
  #pragma unroll
  for(int r=4;r<16;r+=4){a=max3f(a,p0[r],p0[r+1]);b=max3f(b,p0[r+2],p0[r+3]);a=max3f(a,p1[r],p1[r+1]);b=max3f(b,p1[r+2],p1[r+3]);}
  const float m=max2f(a,b);
  auto rr=__builtin_amdgcn_permlane32_swap(__float_as_uint(m),__float_as_uint(m),false,false);
  return max2f(__uint_as_float(rr[0]),__uint_as_float(rr[1]));
}
__device__ __forceinline__ void pv(f32x16*o,int vb,bf16x8 pa0,bf16x8 pa1,bf16x8 pa2,bf16x8 pa3){
  #pragma unroll
  for(int d0=0;d0<2;++d0){s16x4 lo[4],hi[4];
    #pragma unroll
    for(int ks=0;ks<4;++ks){
      asm volatile("ds_read_b64_tr_b16 %0,%1 offset:%c2":"=&v"(lo[ks]):"v"(vb),"i"(d0*4096+ks*1024):"memory");
      asm volatile("ds_read_b64_tr_b16 %0,%1 offset:%c2":"=&v"(hi[ks]):"v"(vb),"i"(d0*4096+ks*1024+512):"memory");}
    asm volatile("s_waitcnt lgkmcnt(0)":::"memory");SBAR();
    #define PK(k) (bf16x8){lo[k][0],lo[k][1],lo[k][2],lo[k][3],hi[k][0],hi[k][1],hi[k][2],hi[k][3]}
    o[d0]=__builtin_amdgcn_mfma_f32_32x32x16_bf16(pa0,PK(0),o[d0],0,0,0);
    o[d0]=__builtin_amdgcn_mfma_f32_32x32x16_bf16(pa1,PK(1),o[d0],0,0,0);
    o[d0]=__builtin_amdgcn_mfma_f32_32x32x16_bf16(pa2,PK(2),o[d0],0,0,0);
    o[d0]=__builtin_amdgcn_mfma_f32_32x32x16_bf16(pa3,PK(3),o[d0],0,0,0);
    #undef PK
  }
}

#ifndef ATTN_STORE16
#define ATTN_STORE16(p,v) (*(u32x4*)(p)=(v))
#endif
template<int THRL,bool MOBA,bool V128> __device__ __forceinline__ void attn_unit(int qb,const bf16*Qh,const bf16*Kh,const bf16*Vh,bf16*Oh,const bf16*Gh,const float*km,char*shm,int wv_){
  int tid_=wv_*64+lane_id_opaque(); asm volatile("":"+v"(tid_)); const int tid=tid_,lane=tid&63,r32=lane&31,hi=lane>>5; const int wid=__builtin_amdgcn_readfirstlane(tid>>6);
  const int q0=qb*QB;
  const bf16*Qw=Qh+(long)(q0+wid*QBLK)*DM;
  const unsigned lds0=(unsigned)(uintptr_t)shm;
  float*wsf=(float*)(shm+LDS_WS)+wid*64;
  const bf16*ksrc=Kh+(long)lane*DM+wid*8;
  const bf16*vsrc=Vh+(long)(16*(wid&3)+(lane>>2))*DM+(wid>>2)*32+(lane&3)*8;
  const unsigned kdst=lds0+LDS_K+wid*1024, vdst=lds0+LDS_V+wid*1024;
  #define DMA_K(t,slot) glds16(ksrc+(long)(t)*KVBLK*DM,(unsigned)__builtin_amdgcn_readfirstlane(kdst+(slot)))
  #define DMA_V(t,slot) do{ glds16(vsrc+(long)(t)*KVBLK*DM,(unsigned)__builtin_amdgcn_readfirstlane(vdst+(slot))); if constexpr(V128) glds16(vsrc+64+(long)(t)*KVBLK*DM,(unsigned)__builtin_amdgcn_readfirstlane(vdst+(LDS_V2-LDS_V)+(slot))); }while(0)
  #define WAIT_STEP() do{ if constexpr(V128){WAIT_BAR(3);} else {WAIT_BAR(2);} }while(0)
  const int vb0=(int)(lds0+LDS_V)+((lane>>4)&1)*32+(lane&3)*8+(4*hi+((lane&15)>>2))*64;
  const char*Kbase=shm+LDS_K; bf16x8 kf[8];
  const lds_cptr shm3=(lds_cptr)shm; const lds_cptr kp0=shm3+LDS_K+hi*1024+r32*16; const lds_cptr vp0=shm3+LDS_V+((lane>>4)&1)*32+(lane&3)*8+(4*hi+((lane&15)>>2))*64;
  unsigned selm=0u; bool active=true;
  #define MOBA_STAGE() do{ if constexpr(MOBA){ if(tid<qb*16){ const f32x4_t kv_=((const f32x4_t*)km)[tid]; *(__attribute__((address_space(3))) f32x4_t*)(shm3+LDS_OST+tid*16)=kv_; } } }while(0)
  #define MOBA_GATE() do{ if constexpr(MOBA){ \
      float qf[32]; \
      _Pragma("unroll") for(int d0=0;d0<4;++d0) _Pragma("unroll") for(int i=0;i<8;++i) qf[d0*8+i]=__uint_as_float(((unsigned)(unsigned short)qr[d0][i])<<16); \
      float v1=-INFINITY,v2=-INFINITY,v3=-INFINITY; unsigned m1=0u,m2=0u,m3=0u; \
      const __attribute__((address_space(3))) f32x4_t* kml=(const __attribute__((address_space(3))) f32x4_t*)(shm3+LDS_OST)+hi*2; \
      for(int n=0;n<qb;++n){ float g=0.f; \
        _Pragma("unroll") for(int d0=0;d0<4;++d0){ const f32x4_t a_=kml[n*16+d0*4], b_=kml[n*16+d0*4+1]; \
          g+=qf[d0*8+0]*a_.x; g+=qf[d0*8+1]*a_.y; g+=qf[d0*8+2]*a_.z; g+=qf[d0*8+3]*a_.w; g+=qf[d0*8+4]*b_.x; g+=qf[d0*8+5]*b_.y; g+=qf[d0*8+6]*b_.z; g+=qf[d0*8+7]*b_.w; } \
        g=half_sum(g); const unsigned bit=1u<<n; \
        if(g>v1){v3=v2;m3=m2;v2=v1;m2=m1;v1=g;m1=bit;} else if(g>v2){v3=v2;m3=m2;v2=g;m2=bit;} else if(g>v3){v3=g;m3=bit;} } \
      selm=m1|m2|m3|(1u<<qb); active=(selm&1u)!=0u; } }while(0)
  #define MOBA_T0(P0,P1) do{ if constexpr(MOBA){ if(!active){ _Pragma("unroll") for(int r=0;r<16;++r){P0[r]=0.f;P1[r]=0.f;} } } }while(0)
  #define BLK(tt) do{ if constexpr(MOBA){ if((((tt))&3)==0){ active=((selm>>((tt)>>2))&1u)!=0u; const float nv_=active?-mhat:-INFINITY; _Pragma("unroll") for(int r=0;r<16;++r)negm[r]=nv_; asm volatile("":"+v"(negm)); } } }while(0)
  const int NT=(q0+QB)/KVBLK;
  DMA_K(0,0);DMA_V(0,0);DMA_K(1,SLOTB);
  bf16x8 qr[4];
  #pragma unroll
  for(int d0=0;d0<4;++d0)qr[d0]=*reinterpret_cast<const bf16x8*>(&Qw[(long)r32*DM+d0*16+hi*8]);
  float mhat=0.f,l_reg=0.f;f32x16 o[V128?4:2]; _Pragma("unroll") for(int i_=0;i_<(V128?4:2);++i_)o[i_]=f32x16{};f32x16 negm=f32x16{}; if constexpr(true){ float z_=0.f; asm volatile("":"+v"(z_)); _Pragma("unroll") for(int r=0;r<16;++r)negm[r]=z_; asm volatile("":"+v"(negm)); }
  const int qrel=wid*QBLK+r32;
  #define CMASK(P0,P1,t) do{int jb_=(t)-(NT-4); if(jb_>=0)cmask(P0,P1,jb_,qrel,hi);}while(0)
  bool resc=false;
  #define START(P0,P1) do{ const float rm=rowmax(P0,P1); resc=false; \
    { const float dl=rm; mhat=fadd_s(mhat,dl); \
      _Pragma("unroll") for(int r=0;r<16;++r){P0[r]=fsub_s(P0[r],dl);P1[r]=fsub_s(P1[r],dl);} \
      if constexpr(true){ { const float nv_=(MOBA&&!active)?-INFINITY:-mhat; _Pragma("unroll") for(int r=0;r<16;++r)negm[r]=nv_; } asm volatile("":"+v"(negm)); } } \
    _Pragma("unroll") for(int r=0;r<16;++r)P0[r]=__builtin_amdgcn_exp2f(P0[r]); }while(0)
  #define RESC() do{ if(resc){ asm volatile("s_waitcnt lgkmcnt(0)":::"memory"); \
      _Pragma("unroll") for(int d_=0;d_<(V128?4:2);++d_) _Pragma("unroll") for(int r=0;r<16;++r)o[d_][r]*=wsf[crow(r,hi)]; } }while(0)
  f32x16 pA0,pA1,pB0,pB1;
  int sl_prev=0,sl_cur=0,sl_next=SLOTB;
  #define ROT() do{sl_prev=sl_cur;sl_cur=sl_next;sl_next=(sl_next==(NSLOT-1)*SLOTB)?0:sl_next+SLOTB;}while(0)
  DMA_K(2,2*SLOTB);
  MOBA_STAGE();
  WAIT_BAR(3);
  MOBA_GATE();
  qkt(pA0,pA1,Kbase,qr,negm,r32,hi);asm volatile("s_nop 15\n\ts_nop 7":"+v"(pA0),"+v"(pA1));CMASK(pA0,pA1,0);
  START(pA0,pA1);
  _Pragma("unroll") for(int r=0;r<16;++r)pA1[r]=__builtin_amdgcn_exp2f(pA1[r]);
  MOBA_T0(pA0,pA1);
  WAIT_BAR(0);
  DMA_K(3,0);DMA_V(1,SLOTB);
  ROT();
  kload8(kf,kp0+sl_cur);
  WAIT_STEP();
  s16x4 vlo[8],vhi[8]; u32x4 pw0,pw1,pw2,pw3;
  #define PKW(P,B) cvtpk_s(P[B],P[B+1])
  #define PAF(k) __builtin_bit_cast(bf16x8,pw##k)
  #define VFR(i) (bf16x8){vlo[i][0],vlo[i][1],vlo[i][2],vlo[i][3],vhi[i][0],vhi[i][1],vhi[i][2],vhi[i][3]}
  #define PIN(x) asm volatile("":"+v"(x))
  #define MX3(a,b,c) __builtin_fmaxf(__builtin_fmaxf((a),(b)),(c))
  #define GAPA(MF,A0,A1,A2,A3,W0,W1,PW) do{ MF; sacc+=A0; sacc+=A1; sacc+=A2; sacc+=A3; PIN(sacc); W0; W1; PIN(PW); SBAR(); }while(0)
  #define EX(v) __builtin_amdgcn_exp2f(v)
  #define GAPB(MF,X,B) do{ MF; X[B]=EX(X[B]); X[B+1]=EX(X[B+1]); X[B+2]=EX(X[B+2]); X[B+3]=EX(X[B+3]); PIN(X); SBAR(); }while(0)
  #define CINIT negm
  #define GAPB2(MF,X,B) do{ MF; X[B]=EX(X[B]); X[B+1]=EX(X[B+1]); PIN(X); SBAR(); }while(0)
  #define VRDS(s,i,base) do{ vlo[s]=vtr(base+(((i)>>2)*4096+((i)&3)*1024)); vhi[s]=vtr(base+(((i)>>2)*4096+((i)&3)*1024+512)); SBAR(); }while(0)
  #define VFS(s) (bf16x8){vlo[s][0],vlo[s][1],vlo[s][2],vlo[s][3],vhi[s][0],vhi[s][1],vhi[s][2],vhi[s][3]}
  #define VRD(i) do{ if constexpr(V128){ if(((i)&3)<2){ vlo[((i)&3)*2+((i)>>2)]=vtr(vp_+(((i)>>2)*4096+((i)&3)*1024)); vhi[((i)&3)*2+((i)>>2)]=vtr(vp_+(((i)>>2)*4096+((i)&3)*1024+512)); } } else { vlo[i]=vtr(vp_+(((i)>>2)*4096+((i)&3)*1024)); vhi[i]=vtr(vp_+(((i)>>2)*4096+((i)&3)*1024+512)); } }while(0)
  #define KRD(G,j) do{ if(G){ kload2(kf,kp0+sl_next,j); SBAR(); } }while(0)
  #define STEP(C0,C1,P0,P1,t,GK,GV,GL) do{ SBAR(); \
    const lds_cptr vp_=vp0+sl_prev; \
    VRD(0); SBAR(); float sacc=(P0[0]+P0[1]); \
    GAPA(C0=__builtin_amdgcn_mfma_f32_32x32x16_bf16(kf[0],qr[0],CINIT,0,0,0), P0[2],P0[3],P0[4],P0[5],     pw0[0]=PKW(P0,0), pw0[1]=PKW(P0,2), pw0); \
    VRD(4); SBAR(); GAPA(C1=__builtin_amdgcn_mfma_f32_32x32x16_bf16(kf[1],qr[0],CINIT,0,0,0), P0[6],P0[7],P0[8],P0[9],     pw0[2]=PKW(P0,4), pw0[3]=PKW(P0,6), pw0); \
    VRD(1); SBAR(); GAPA(C0=__builtin_amdgcn_mfma_f32_32x32x16_bf16(kf[2],qr[1],C0,0,0,0),   P0[10],P0[11],P0[12],P0[13], pw1[0]=PKW(P0,8), pw1[1]=PKW(P0,10), pw1); \
    VRD(5); SBAR(); GAPA(C1=__builtin_amdgcn_mfma_f32_32x32x16_bf16(kf[3],qr[1],C1,0,0,0),   P0[14],P0[15],P1[0],P1[1],   pw1[2]=PKW(P0,12),pw1[3]=PKW(P0,14), pw1); \
    VRD(2); SBAR(); GAPA(C0=__builtin_amdgcn_mfma_f32_32x32x16_bf16(kf[4],qr[2],C0,0,0,0),   P1[2],P1[3],P1[4],P1[5],     pw2[0]=PKW(P1,0), pw2[1]=PKW(P1,2), pw2); \
    VRD(6); SBAR(); GAPA(C1=__builtin_amdgcn_mfma_f32_32x32x16_bf16(kf[5],qr[2],C1,0,0,0),   P1[6],P1[7],P1[8],P1[9],     pw2[2]=PKW(P1,4), pw2[3]=PKW(P1,6), pw2); \
    VRD(3); SBAR(); GAPA(C0=__builtin_amdgcn_mfma_f32_32x32x16_bf16(kf[6],qr[3],C0,0,0,0),   P1[10],P1[11],P1[12],P1[13], pw3[0]=PKW(P1,8), pw3[1]=PKW(P1,10), pw3); \
    VRD(7); SBAR(); GAPA(C1=__builtin_amdgcn_mfma_f32_32x32x16_bf16(kf[7],qr[3],C1,0,0,0),   P1[14],P1[15],0.f,0.f,       pw3[2]=PKW(P1,12),pw3[3]=PKW(P1,14), pw3); \
    l_reg+=sacc; \
    if(GK){DMA_K((t)+3,sl_cur);} if(GV){DMA_V((t)+1,sl_next);} \
    CMASK(C0,C1,t); \
    { float a=MX3(C0[0],C0[1],C1[0]),b=MX3(C0[2],C0[3],C1[1]); a=MX3(a,C1[2],C1[3]); \
      _Pragma("unroll") for(int r=4;r<16;r+=4){a=MX3(a,C0[r],C0[r+1]);b=MX3(b,C0[r+2],C0[r+3]);a=MX3(a,C1[r],C1[r+1]);b=MX3(b,C1[r+2],C1[r+3]);} \
      float rm=__builtin_fmaxf(a,b); { auto rr=__builtin_amdgcn_permlane32_swap(__float_as_uint(rm),__float_as_uint(rm),false,false); rm=__builtin_fmaxf(__uint_as_float(rr[0]),__uint_as_float(rr[1])); } \
      resc=false; \
      if(__builtin_expect(__any(rm>(float)THRL),0)){ const float dl=__builtin_fmaxf(rm,0.f); mhat+=dl; \
        _Pragma("unroll") for(int r=0;r<16;++r){C0[r]-=dl;C1[r]-=dl;} \
        if constexpr(true){ { const float nv_=(MOBA&&!active)?-INFINITY:-mhat; _Pragma("unroll") for(int r=0;r<16;++r)negm[r]=nv_; } asm volatile("":"+v"(negm)); } \
        const float f=__builtin_amdgcn_exp2f(-dl); l_reg*=f; if(hi==0)wsf[r32]=f; resc=true; } } \
    SBAR(); \
    if constexpr(V128){ const lds_cptr vp2_=vp_+(LDS_V2-LDS_V); \
    GAPB2(o[0]=__builtin_amdgcn_mfma_f32_32x32x16_bf16(PAF(0),VFS(0),o[0],0,0,0), C0,0); VRDS(0,2,vp_); \
    GAPB2(o[1]=__builtin_amdgcn_mfma_f32_32x32x16_bf16(PAF(0),VFS(1),o[1],0,0,0), C0,2); VRDS(1,6,vp_); \
    KRD(GL,0); GAPB2(o[0]=__builtin_amdgcn_mfma_f32_32x32x16_bf16(PAF(1),VFS(2),o[0],0,0,0), C0,4); VRDS(2,3,vp_); \
    KRD(GL,1); GAPB2(o[1]=__builtin_amdgcn_mfma_f32_32x32x16_bf16(PAF(1),VFS(3),o[1],0,0,0), C0,6); VRDS(3,7,vp_); \
    KRD(GL,2); GAPB2(o[0]=__builtin_amdgcn_mfma_f32_32x32x16_bf16(PAF(2),VFS(0),o[0],0,0,0), C0,8); VRDS(0,0,vp2_); \
    KRD(GL,3); GAPB2(o[1]=__builtin_amdgcn_mfma_f32_32x32x16_bf16(PAF(2),VFS(1),o[1],0,0,0), C0,10); VRDS(1,4,vp2_); \
    GAPB2(o[0]=__builtin_amdgcn_mfma_f32_32x32x16_bf16(PAF(3),VFS(2),o[0],0,0,0), C0,12); VRDS(2,1,vp2_); \
    GAPB2(o[1]=__builtin_amdgcn_mfma_f32_32x32x16_bf16(PAF(3),VFS(3),o[1],0,0,0), C0,14); VRDS(3,5,vp2_); \
    GAPB2(o[2]=__builtin_amdgcn_mfma_f32_32x32x16_bf16(PAF(0),VFS(0),o[2],0,0,0), C1,0); VRDS(0,2,vp2_); \
    GAPB2(o[3]=__builtin_amdgcn_mfma_f32_32x32x16_bf16(PAF(0),VFS(1),o[3],0,0,0), C1,2); VRDS(1,6,vp2_); \
    GAPB2(o[2]=__builtin_amdgcn_mfma_f32_32x32x16_bf16(PAF(1),VFS(2),o[2],0,0,0), C1,4); VRDS(2,3,vp2_); \
    GAPB2(o[3]=__builtin_amdgcn_mfma_f32_32x32x16_bf16(PAF(1),VFS(3),o[3],0,0,0), C1,6); VRDS(3,7,vp2_); \
    GAPB2(o[2]=__builtin_amdgcn_mfma_f32_32x32x16_bf16(PAF(2),VFS(0),o[2],0,0,0), C1,8); \
    GAPB2(o[3]=__builtin_amdgcn_mfma_f32_32x32x16_bf16(PAF(2),VFS(1),o[3],0,0,0), C1,10); \
    GAPB2(o[2]=__builtin_amdgcn_mfma_f32_32x32x16_bf16(PAF(3),VFS(2),o[2],0,0,0), C1,12); \
    GAPB2(o[3]=__builtin_amdgcn_mfma_f32_32x32x16_bf16(PAF(3),VFS(3),o[3],0,0,0), C1,14); \
    } else { \
    GAPB(o[0]=__builtin_amdgcn_mfma_f32_32x32x16_bf16(PAF(0),VFR(0),o[0],0,0,0), C0,0); \
    GAPB(o[1]=__builtin_amdgcn_mfma_f32_32x32x16_bf16(PAF(0),VFR(4),o[1],0,0,0), C0,4); \
    KRD(GL,0); GAPB(o[0]=__builtin_amdgcn_mfma_f32_32x32x16_bf16(PAF(1),VFR(1),o[0],0,0,0), C0,8); \
    KRD(GL,1); GAPB(o[1]=__builtin_amdgcn_mfma_f32_32x32x16_bf16(PAF(1),VFR(5),o[1],0,0,0), C0,12); \
    KRD(GL,2); GAPB(o[0]=__builtin_amdgcn_mfma_f32_32x32x16_bf16(PAF(2),VFR(2),o[0],0,0,0), C1,0); \
    KRD(GL,3); GAPB(o[1]=__builtin_amdgcn_mfma_f32_32x32x16_bf16(PAF(2),VFR(6),o[1],0,0,0), C1,4); \
    GAPB(o[0]=__builtin_amdgcn_mfma_f32_32x32x16_bf16(PAF(3),VFR(3),o[0],0,0,0), C1,8); \
    GAPB(o[1]=__builtin_amdgcn_mfma_f32_32x32x16_bf16(PAF(3),VFR(7),o[1],0,0,0), C1,12); \
    } \
    }while(0)
  int t=1;
  #undef CMASK
  #define CMASK(P0,P1,t) do{}while(0)
  for(;t+5<NT;t+=2){
    STEP(pB0,pB1,pA0,pA1,t,true,true,true);     WAIT_STEP(); RESC(); ROT(); BLK(t+1);
    STEP(pA0,pA1,pB0,pB1,t+1,true,true,true);   WAIT_STEP(); RESC(); ROT();
  }
  #undef CMASK
  #define CMASK(P0,P1,t) do{int jb_=(t)-(NT-4); if(jb_>=0)cmask(P0,P1,jb_,qrel,hi);}while(0)
  #define ENDW(tt) do{ if constexpr(V128){ if((tt)+3<NT){WAIT_BAR(3);} else if((tt)+2<NT){WAIT_BAR(2);} else {WAIT_BAR(0);} } else { if((tt)+3<NT){WAIT_BAR(2);} else if((tt)+2<NT){WAIT_BAR(1);} else {WAIT_BAR(0);} } }while(0)
  for(;t+1<NT;t+=2){
    STEP(pB0,pB1,pA0,pA1,t,(t+3<NT),(t+1<NT),(t+1<NT));       ENDW(t);   RESC(); ROT(); BLK(t+1);
    STEP(pA0,pA1,pB0,pB1,t+1,(t+4<NT),(t+2<NT),(t+2<NT));     ENDW(t+1); RESC(); ROT();
  }
  STEP(pB0,pB1,pA0,pA1,NT-1,false,false,false); RESC();
  { float sacc=pB0[0]+pB0[1]; _Pragma("unroll") for(int r=2;r<16;++r)sacc+=pB0[r]; _Pragma("unroll") for(int r=0;r<16;++r)sacc+=pB1[r]; l_reg+=sacc;
    pw0=(u32x4){PKW(pB0,0),PKW(pB0,2),PKW(pB0,4),PKW(pB0,6)};pw1=(u32x4){PKW(pB0,8),PKW(pB0,10),PKW(pB0,12),PKW(pB0,14)};pw2=(u32x4){PKW(pB1,0),PKW(pB1,2),PKW(pB1,4),PKW(pB1,6)};pw3=(u32x4){PKW(pB1,8),PKW(pB1,10),PKW(pB1,12),PKW(pB1,14)};
    SBAR(); pv(o,vb0+sl_cur,PAF(0),PAF(1),PAF(2),PAF(3)); if constexpr(V128){ SBAR(); pv(o+2,vb0+sl_cur+(LDS_V2-LDS_V),PAF(0),PAF(1),PAF(2),PAF(3)); } }
  #undef PKW
  #undef PAF
  #undef VFR
  #undef PIN
  #undef MX3
  #undef GAPA
  #undef GAPB
  #undef GAPB2
  #undef CINIT
  #undef VRDS
  #undef VFS
  #undef EX
  #undef VRD
  #undef KRD
  #undef STEP
  #undef ENDW
  {auto rr=__builtin_amdgcn_permlane32_swap(__float_as_uint(l_reg),__float_as_uint(l_reg),false,false);l_reg=__uint_as_float(rr[0])+__uint_as_float(rr[1]);}
  if(hi==0)wsf[32+r32]=l_reg;asm volatile("s_waitcnt lgkmcnt(0)":::"memory");
  float rli[16];
  #pragma unroll
  for(int r=0;r<16;++r)rli[r]=__builtin_amdgcn_rcpf(wsf[32+crow(r,hi)]);
  bf16*Ow=Oh+(long)(q0+wid*QBLK)*DM; const bf16*Gw=MOBA?Gh+(long)(q0+wid*QBLK)*DM:nullptr;
  _Pragma("unroll") for(int hp=0;hp<(V128?2:1);++hp)
  { bf16*stg=(bf16*)(shm+LDS_OST)+wid*2048;
    #pragma unroll
    for(int r=0;r<16;++r){const int orow=crow(r,hi);
      #pragma unroll
      for(int d0=0;d0<2;++d0)stg[orow*64+d0*32+r32]=__float2bfloat16(o[2*hp+d0][r]*rli[r]);}
    asm volatile("s_waitcnt lgkmcnt(0)":::"memory");
    #pragma unroll
    for(int i=0;i<4;++i){const int row=i*8+(lane>>3),ch=lane&7; u32x4 v=*(const u32x4*)(stg+row*64+ch*8);
      if constexpr(MOBA){ const u32x4 gg=__builtin_nontemporal_load((const u32x4*)(Gw+(long)row*DM+ch*8));
        _Pragma("unroll") for(int k=0;k<4;++k){ const float lo=__uint_as_float(v[k]<<16)*__uint_as_float(gg[k]<<16), hi_=__uint_as_float(v[k]&0xffff0000u)*__uint_as_float(gg[k]&0xffff0000u); v[k]=cvtpk_s(lo,hi_);} }
      ATTN_STORE16(Ow+(long)row*DM+hp*64+ch*8,v);}
    asm volatile("s_waitcnt lgkmcnt(0)":::"memory"); }
  asm volatile("s_waitcnt lgkmcnt(0)\n\ts_barrier":::"memory");
  #undef DMA_K
  #undef DMA_V
  #undef WAIT_STEP
  #undef CMASK
  #undef START
  #undef RESC
  #undef ROT
  #undef MOBA_STAGE
  #undef MOBA_GATE
  #undef MOBA_T0
  #undef BLK
}
constexpr int ATTN_LDS_BYTES=LDS_BYTES;
#undef SBAR
#undef WAIT_BAR
}
constexpr int NWAVES = 8;
constexpr int BATCH = 2, T = 8192, D = 1024, M = BATCH * T, NIN = 6144, PLE = 256, DW = 512;
constexpr size_t MiB = 1u << 20;
constexpr size_t WS_CTL = 0, CTL_ZERO_BYTES = 1 * MiB, WS_KMEAN = 512 * 1024;
constexpr size_t WS_WIN = 2 * MiB, WS_WD = 14 * MiB, WS_WM = 15 * MiB, WS_WO = 16 * MiB, WS_WG = 18 * MiB, WS_WP = 20 * MiB, WS_ROPE = 21 * MiB, WS_PB = 22 * MiB;
constexpr size_t WS_XN = 32 * MiB;
constexpr size_t WS_DQ = 64 * MiB, WS_DK = 80 * MiB, WS_DV = 96 * MiB, WS_DG = 112 * MiB, WS_MQ = 128 * MiB, WS_MK = 144 * MiB, WS_MV = 160 * MiB, WS_MG = 176 * MiB;
constexpr size_t WS_GA = 192 * MiB, WS_GB = 224 * MiB, WS_END = 256 * MiB;
constexpr size_t WS_OA = WS_DQ;
constexpr size_t WS_MERGED = WS_DK;
constexpr size_t WS_X1B = WS_MK;
constexpr int CW_Q = 16320;
constexpr int CW_LOC = 12288;
constexpr int CW_BAR = 4096, CW_SEAM = 8192;
constexpr size_t WS_XBUF = 640 * 1024;
constexpr int RING_OFF = 0, RING_BYTES = 131072;
constexpr int LDSCTL_OFF = RING_BYTES, MISC_OFF = LDSCTL_OFF + 320;
constexpr int LDS_BYTES = 147456;

#define GAS __attribute__((address_space(1)))
#define LAS __attribute__((address_space(3)))
typedef unsigned short bf16;
typedef unsigned v4u __attribute__((ext_vector_type(4)));
typedef unsigned v2u __attribute__((ext_vector_type(2)));
typedef float f32x4 __attribute__((ext_vector_type(4)));
#define LDS_WAIT() asm volatile("s_waitcnt lgkmcnt(0)" ::: "memory")
#define VM_WAIT() asm volatile("s_waitcnt vmcnt(0)" ::: "memory")
__device__ __forceinline__ unsigned f2bf(float f) { unsigned u = __builtin_bit_cast(unsigned, f); return (u + 0x7fffu + ((u >> 16) & 1u)) >> 16; }
__device__ __forceinline__ unsigned pk2(float lo, float hi) { return f2bf(lo) | (f2bf(hi) << 16); }
__device__ __forceinline__ float blo(unsigned w) { return __uint_as_float(w << 16); }
__device__ __forceinline__ float bhi(unsigned w) { return __uint_as_float(w & 0xffff0000u); }

struct Frame {
    LAS unsigned char* lds;
    int tid, lane, wave, vcu, G;
};
struct Args { const float* in[15]; float* out; unsigned char* ws; };
typedef const __attribute__((address_space(4))) Args* KArgs;
__device__ __forceinline__ KArgs kargs_ptr() { KArgs a = (KArgs)__builtin_amdgcn_kernarg_segment_ptr(); asm volatile("" : "+s"(a)); return a; }
__device__ __forceinline__ Frame mk_frame(unsigned char* lds, int wv) {
    Frame F; F.lds = (LAS unsigned char*)lds;
    asm volatile("" : "+s"(wv));
    int tid = wv * 64 + lane_id_opaque(); asm volatile("" : "+v"(tid));
    int bx = blockIdx.x, G = gridDim.x; asm volatile("" : "+s"(bx), "+s"(G));
    F.tid = tid; F.lane = tid & 63; F.wave = wv;
    F.G = G; F.vcu = (G % 8 == 0) ? (bx % 8) * (G / 8) + bx / 8 : bx;
    return F;
}
__device__ __forceinline__ float wave_sum(float v) {
    v += swz_xor<1>(v); v += swz_xor<2>(v); v += swz_xor<4>(v); v += swz_xor<8>(v); v += swz_xor<16>(v);
    return half_sum(v);
}
__device__ __forceinline__ void p0_transpose_item(const float* W, int K, int N, bf16* WT, LAS float* scr, int item, int lane) {
    const int nblk = N / 32, kb = item / nblk, nb = item % nblk, k0 = 64 * kb, n0 = 32 * nb;
#pragma unroll 16
    for (int i = 0; i < 32; ++i) { const int kk = 2 * i + (lane >> 5); scr[kk * 33 + (lane & 31)] = __builtin_nontemporal_load(W + (size_t)(k0 + kk) * N + n0 + (lane & 31)); }
    LDS_WAIT(); asm volatile("" ::: "memory");
    const int c = lane & 7;
#pragma unroll
    for (int j = 0; j < 4; ++j) { const int n = (lane >> 3) + 8 * j; const LAS float* s = scr + (8 * c) * 33 + n;
        v4u o; o.x = pk2(s[0 * 33], s[1 * 33]); o.y = pk2(s[2 * 33], s[3 * 33]); o.z = pk2(s[4 * 33], s[5 * 33]); o.w = pk2(s[6 * 33], s[7 * 33]);
        *(GAS v4u*)(WT + (size_t)(n0 + n) * K + k0 + 8 * c) = o; }
    LDS_WAIT(); asm volatile("" ::: "memory");
}
__constant__ float ROPE_INV[8] = {1.0f, 0.1939227432012558f, 0.03760603070259094f, 0.007292664609849453f, 0.0014142135623842478f, 0.00027424818836152554f, 5.318296098266728e-05f, 1.0313386155758053e-05f};

__device__ __forceinline__ void p0_prologue(unsigned char* ldsp, int wv) {
    Frame F = mk_frame(ldsp, wv); KArgs ka = kargs_ptr();
    unsigned char* ws = ka->ws;
    LAS float* scr = (LAS float*)(F.lds + RING_OFF + F.wave * 16384);
    const int gw = F.vcu * NWAVES + F.wave, NGW = F.G * NWAVES;
    constexpr int I_IN = (D / 64) * (NIN / 32), I_D = (DW / 64) * (D / 32), I_O = (D / 64) * (D / 32), I_P = (PLE / 64) * (D / 32);
    (void)I_D; (void)I_O; (void)I_P;
    for (int it = gw; it < I_IN; it += NGW) p0_transpose_item(ka->in[3], D, NIN, (bf16*)(ws + WS_WIN), scr, it, F.lane);
    {
        const GAS f32x4* gp = (const GAS f32x4*)ka->in[2] + F.lane; f32x4 gv[4];
#pragma unroll
        for (int j = 0; j < 4; ++j) gv[j] = gp[64 * j];
        for (int m = gw; m < M; m += 2 * NGW) {
            const int m2 = m + NGW; const bool has2 = m2 < M; const int mb = has2 ? m2 : m;
            const GAS f32x4* xr = (const GAS f32x4*)(ka->in[0] + (size_t)m * D) + F.lane; const GAS f32x4* xr2 = (const GAS f32x4*)(ka->in[0] + (size_t)mb * D) + F.lane;
            f32x4 v[4], w[4]; float s = 0.f, s2 = 0.f;
#pragma unroll
            for (int j = 0; j < 4; ++j) { v[j] = __builtin_nontemporal_load(xr + 64 * j); w[j] = __builtin_nontemporal_load(xr2 + 64 * j); }
#pragma unroll
            for (int j = 0; j < 4; ++j) { s += (v[j].x * v[j].x + v[j].y * v[j].y) + (v[j].z * v[j].z + v[j].w * v[j].w); s2 += (w[j].x * w[j].x + w[j].y * w[j].y) + (w[j].z * w[j].z + w[j].w * w[j].w); }
            const float rstd = 1.f / sqrtf(wave_sum(s) * (1.f / D) + 1e-6f), rstd2 = 1.f / sqrtf(wave_sum(s2) * (1.f / D) + 1e-6f);
            GAS unsigned long long* o8 = (GAS unsigned long long*)(ws + WS_XN + (size_t)m * D * 2) + F.lane;
#pragma unroll
            for (int j = 0; j < 4; ++j) { const f32x4 y = v[j] * rstd * gv[j]; o8[64 * j] = (unsigned long long)pk2(y.x, y.y) | ((unsigned long long)pk2(y.z, y.w) << 32); }
            if (has2) { GAS unsigned long long* p8 = (GAS unsigned long long*)(ws + WS_XN + (size_t)m2 * D * 2) + F.lane;
#pragma unroll
                for (int j = 0; j < 4; ++j) { const f32x4 y = w[j] * rstd2 * gv[j]; p8[64 * j] = (unsigned long long)pk2(y.x, y.y) | ((unsigned long long)pk2(y.z, y.w) << 32); } }
        }
    }
    for (int idx = gw * 64 + F.lane; idx < T * 8; idx += NGW * 64) {
        const int pos = idx >> 3, j = idx & 7; const float ang = (float)pos * ROPE_INV[j];
        const double a = (double)ang; const double k = rint(a * 0.15915494309189535); const float r = (float)(a - k * 6.283185307179586);
        float* tp = (float*)(ws + WS_ROPE) + (size_t)pos * 16 + j; tp[0] = cosf(r); tp[8] = sinf(r);
    }
    for (int idx = gw * 64 + F.lane; idx < 2 * 8 * 32 * 64; idx += NGW * 64) ((float*)(ws + WS_KMEAN))[idx] = 0.f;
}

__device__ __forceinline__ void p2_pre(unsigned char* ldsp, int wv) {
    Frame F = mk_frame(ldsp, wv); KArgs ka = kargs_ptr();
    unsigned char* ws = ka->ws;
    LAS float* scr = (LAS float*)(F.lds + RING_OFF + F.wave * 16384);
    const int gw = F.vcu * NWAVES + F.wave, NGW = F.G * NWAVES;
    constexpr int I_D = (DW / 64) * (D / 32), I_O = (D / 64) * (D / 32), I_P = (PLE / 64) * (D / 32);
    constexpr int NITEMS = 2 * I_D + 2 * I_O + I_P;
    for (int it = gw; it < NITEMS; it += NGW) {
        int r = it;
        if (r < I_D) { p0_transpose_item(ka->in[9], DW, D, (bf16*)(ws + WS_WD), scr, r, F.lane); continue; } r -= I_D;
        if (r < I_D) { p0_transpose_item(ka->in[10], DW, D, (bf16*)(ws + WS_WM), scr, r, F.lane); continue; } r -= I_D;
        if (r < I_O) { p0_transpose_item(ka->in[11], D, D, (bf16*)(ws + WS_WO), scr, r, F.lane); continue; } r -= I_O;
        if (r < I_O) { p0_transpose_item(ka->in[13], D, D, (bf16*)(ws + WS_WG), scr, r, F.lane); continue; } r -= I_O;
        p0_transpose_item(ka->in[12], PLE, D, (bf16*)(ws + WS_WP), scr, r, F.lane);
    }
    for (int m = gw; m < M; m += NGW) {
        const f32x4 v = __builtin_nontemporal_load((const GAS f32x4*)(ka->in[1] + (size_t)m * PLE) + F.lane);
        *((GAS unsigned long long*)(ws + WS_PB + (size_t)m * PLE * 2) + F.lane) = (unsigned long long)pk2(v.x, v.y) | ((unsigned long long)pk2(v.z, v.w) << 32);
    }
    LDS_WAIT(); __syncthreads();
}
__device__ __forceinline__ void p2_attention(unsigned char* ldsg, int wv) {
    Frame F = mk_frame(ldsg, wv); unsigned char* ws = kargs_ptr()->ws;
    using abf = attn_body::bf16;
    volatile LAS unsigned* MI = (volatile LAS unsigned*)(F.lds + MISC_OFF);
    unsigned* qhead = (unsigned*)(ws + WS_CTL) + CW_Q;
    const int nP = (F.vcu < 256) ? (256 - F.vcu + F.G - 1) / F.G : 0;
    for (int task = 0; ; ++task) {
        int type, st, qb;
        if (task < 2 * nP) { const int P = F.vcu + (task >> 1) * F.G; type = task & 1; st = P >> 4; qb = 31 - (P & 15); }
        else {
            if (F.tid == 0) MI[14] = __hip_atomic_fetch_add(qhead, 1u, __ATOMIC_RELAXED, __HIP_MEMORY_SCOPE_AGENT);
            __syncthreads();
            const unsigned idx = MI[14];
            __syncthreads();
            if (idx >= 512u) break;
            type = (int)(idx >> 4) & 1; st = (int)idx & 15; qb = 15 - (int)(idx >> 5);
        }
        if (type == 0) { const int mm = st & 1, h = (st >> 1) & 3, b = st >> 3; const size_t rb = (size_t)b * T * DW;
            const abf* Q = (const abf*)(ws + WS_DQ) + rb + (2 * h + mm) * 64; const abf* K = (const abf*)(ws + WS_DK) + rb + (2 * h + mm) * 64;
            const abf* V = (const abf*)(ws + WS_DV) + rb + h * 128; abf* O = (abf*)(ws + WS_XN) + (size_t)mm * M * DW + rb + h * 128;
            attn_body::attn_unit<8, false, true>(qb, Q, K, V, O, nullptr, nullptr, (char*)ldsg, F.wave);
        } else { const int b = st >> 3, h = st & 7; const size_t rb = (size_t)b * T * DW + h * 64;
            abf* Q = (abf*)(ws + WS_MQ) + rb; const abf* K = (const abf*)(ws + WS_MK) + rb; const abf* V = (const abf*)(ws + WS_MV) + rb; const abf* Gt = (const abf*)(ws + WS_MG) + rb;
            const float* km = (const float*)(ws + WS_KMEAN) + (size_t)((b * 8 + h) * 32) * 64;
            attn_body::attn_unit<8, true, false>(qb, Q, K, V, Q, Gt, km, (char*)ldsg, F.wave);
        }
    }
}

__device__ __forceinline__ void p3_combine(unsigned char* ldsp, int wv) {
    Frame F = mk_frame(ldsp, wv); KArgs ka = kargs_ptr();
    unsigned char* ws = ka->ws;
    int gw = F.vcu * NWAVES + F.wave, NGW = F.G * NWAVES, rbase = 0, rend = M;
    { volatile LAS unsigned* MI = (volatile LAS unsigned*)(F.lds + MISC_OFF);
      if (MI[10]) { const int xl = (int)MI[11] >> 3, r = ((int)MI[11] & 7) + 8 * (int)MI[12]; rbase = 2048 * xl; rend = 2048; gw = r * NWAVES + F.wave; NGW = 32 * NWAVES; } }
    const float d1 = wave_sum(ka->in[4][F.lane] * ka->in[5][F.lane]), d2 = wave_sum(ka->in[6][F.lane] * ka->in[7][F.lane]);
    const float lam_init = 0.2f, lam = expf(d1) - expf(d2) + lam_init;
    const int e0 = (8 * F.lane) & 127; float sg[8];
#pragma unroll
    for (int i = 0; i < 8; ++i) sg[i] = ka->in[8][e0 + i] * (1.0f - lam_init);
    for (int m0 = gw; m0 < rend; m0 += 2 * NGW) {
        v4u a[2], b[2], g[2]; size_t off[2]; const bool has2 = (m0 + NGW) < rend;
#pragma unroll
        for (int q = 0; q < 2; ++q) { const int m = rbase + ((q && has2) ? m0 + NGW : m0); off[q] = (size_t)m * DW + 8 * F.lane;
            a[q] = __builtin_nontemporal_load((const GAS v4u*)((const bf16*)(ws + WS_XN) + off[q])); b[q] = __builtin_nontemporal_load((const GAS v4u*)((const bf16*)(ws + WS_XN) + (size_t)M * DW + off[q])); g[q] = __builtin_nontemporal_load((const GAS v4u*)((const bf16*)(ws + WS_DG) + off[q])); }
#pragma unroll
        for (int q = 0; q < 2; ++q) { if (q && !has2) break;
            float d[8]; float ss = 0.f;
#pragma unroll
            for (int k = 0; k < 4; ++k) { d[2 * k] = blo(a[q][k]) - lam * blo(b[q][k]); d[2 * k + 1] = bhi(a[q][k]) - lam * bhi(b[q][k]); ss += d[2 * k] * d[2 * k] + d[2 * k + 1] * d[2 * k + 1]; }
            ss += swz_xor<1>(ss); ss += swz_xor<2>(ss); ss += swz_xor<4>(ss); ss += swz_xor<8>(ss);
            const float rstd = 1.f / sqrtf(ss * (1.f / 128.f) + 1e-5f);
            v4u o;
#pragma unroll
            for (int k = 0; k < 4; ++k) o[k] = pk2(d[2 * k] * rstd * sg[2 * k] * blo(g[q][k]), d[2 * k + 1] * rstd * sg[2 * k + 1] * bhi(g[q][k]));
            *(GAS v4u*)((bf16*)(ws + WS_OA) + off[q]) = o; }
    }
}
__device__ __forceinline__ void p7_final(unsigned char* ldsp, int wv) {
    Frame F = mk_frame(ldsp, wv); KArgs ka = kargs_ptr();
    const int gw = F.vcu * NWAVES + F.wave, NGW = F.G * NWAVES;
    const GAS f32x4* gp = (const GAS f32x4*)ka->in[14] + F.lane; f32x4 gv[4];
#pragma unroll
    for (int j = 0; j < 4; ++j) gv[j] = gp[64 * j];
    for (int m = gw; m < M; m += NGW) {
        GAS f32x4* xr = (GAS f32x4*)(ka->out + (size_t)m * D) + F.lane; f32x4 v[4]; float s = 0.f;
#pragma unroll
        for (int j = 0; j < 4; ++j) { v[j] = xr[64 * j]; s += (v[j].x * v[j].x + v[j].y * v[j].y) + (v[j].z * v[j].z + v[j].w * v[j].w); }
        const float rstd = 1.f / sqrtf(wave_sum(s) * (1.f / D) + 1e-6f);
#pragma unroll
        for (int j = 0; j < 4; ++j) xr[64 * j] = v[j] * rstd * gv[j];
    }
}

__device__ __forceinline__ void p1_inproj(unsigned char* ldsp, int wv) {
    Frame F = mk_frame(ldsp, wv); unsigned char* ws = kargs_ptr()->ws;
    pg8::Gemm g{(const pg8::bf16_t*)(ws + WS_XN), (const pg8::bf16_t*)(ws + WS_WIN), nullptr, nullptr, M, NIN, D};
    pg8::StaticOrder S; S.init(M, NIN, F.G, (int)blockIdx.x);
    pg8::EpiInProj E{ws + WS_DQ, ws + WS_GA, (const float*)(ws + WS_ROPE), (float*)(ws + WS_KMEAN), attn_body::C2};
    pg8::gemm_phase<pg8::EpiInProj, pg8::StaticOrder, true, true>(F.lds + RING_OFF, g, S, E, F.wave);
}
__device__ __forceinline__ void p4a_ple(unsigned char* ldsp, int wv) {
    Frame F = mk_frame(ldsp, wv); unsigned char* ws = kargs_ptr()->ws;
    pg8::Gemm g{(const pg8::bf16_t*)(ws + WS_PB), (const pg8::bf16_t*)(ws + WS_WP), nullptr, nullptr, M, D, PLE};
    pg8::StaticOrder S; S.init(M, D, F.G, (int)blockIdx.x); { volatile LAS unsigned* MI = (volatile LAS unsigned*)(F.lds + MISC_OFF); if (MI[10]) S.fix((int)MI[11], (int)MI[12]); }
    const bool in_out = F.G == 256;
    pg8::EpiStore E{in_out ? (pg8::bf16_t*)kargs_ptr()->out : (pg8::bf16_t*)(ws + WS_XN), in_out ? 2 * D : D, in_out ? 512 : 256};
    pg8::gemm_phase<pg8::EpiStore, pg8::StaticOrder, true, true>(F.lds + RING_OFF, g, S, E, F.wave);
}
__device__ __forceinline__ void p4b_branches(unsigned char* ldsp, int wv) {
    Frame F = mk_frame(ldsp, wv); unsigned char* ws = kargs_ptr()->ws;
    pg8::Gemm g{(const pg8::bf16_t*)(ws + WS_OA), (const pg8::bf16_t*)(ws + WS_WD), (const pg8::bf16_t*)(ws + WS_MQ), (const pg8::bf16_t*)(ws + WS_WM), M, D, DW};
    pg8::PairOrder S; S.init(M, D, F.G, (int)blockIdx.x); { volatile LAS unsigned* MI = (volatile LAS unsigned*)(F.lds + MISC_OFF); if (MI[10]) S.s.fix((int)MI[11], (int)MI[12]); }
    pg8::EpiMerge E{(const pg8::bf16_t*)(ws + WS_GA), (const pg8::bf16_t*)(ws + WS_GB), (pg8::bf16_t*)(ws + WS_MERGED)};
    pg8::gemm_phase<pg8::EpiMerge, pg8::PairOrder, true, true>(F.lds + RING_OFF, g, S, E, F.wave);
}
__device__ __forceinline__ void p5_out(unsigned char* ldsp, int wv) {
    Frame F = mk_frame(ldsp, wv); KArgs ka = kargs_ptr(); unsigned char* ws = ka->ws;
    pg8::Gemm g{(const pg8::bf16_t*)(ws + WS_MERGED), (const pg8::bf16_t*)(ws + WS_WO), nullptr, nullptr, M, D, D};
    pg8::StaticOrder S; S.init(M, D, F.G, (int)blockIdx.x); { volatile LAS unsigned* MI = (volatile LAS unsigned*)(F.lds + MISC_OFF); if (MI[10]) S.fix((int)MI[11], (int)MI[12]); }
    if (F.G == 256) {
        pg8::EpiResid<false> E{ka->in[0], ka->out, (pg8::bf16_t*)(ws + WS_X1B)};
        pg8::gemm_phase<pg8::EpiResid<false>, pg8::StaticOrder, true, true>(F.lds + RING_OFF, g, S, E, F.wave);
    } else {
        pg8::EpiResid<true> E{ka->in[0], ka->out, (pg8::bf16_t*)(ws + WS_X1B)};
        pg8::gemm_phase<pg8::EpiResid<true>, pg8::StaticOrder, true, true>(F.lds + RING_OFF, g, S, E, F.wave);
    }
}
__device__ __forceinline__ void p6_ple(unsigned char* ldsp, int wv) {
    Frame F = mk_frame(ldsp, wv); KArgs ka = kargs_ptr(); unsigned char* ws = ka->ws;
    pg8::Gemm g{(const pg8::bf16_t*)(ws + WS_X1B), (const pg8::bf16_t*)(ws + WS_WG), nullptr, nullptr, M, D, D};
    pg8::StaticOrder S; S.init(M, D, F.G, (int)blockIdx.x); { volatile LAS unsigned* MI = (volatile LAS unsigned*)(F.lds + MISC_OFF); if (MI[10]) S.fix((int)MI[11], (int)MI[12]); }
    if (F.G == 256) {
        pg8::EpiPleNorm E{ka->out, (const pg8::bf16_t*)(ws + WS_X1B), (const pg8::bf16_t*)ka->out, ka->in[14], (float*)(ws + WS_XBUF), (unsigned*)(ws + WS_CTL) + CW_SEAM};
        pg8::gemm_phase<pg8::EpiPleNorm, pg8::StaticOrder, false, true>(F.lds + RING_OFF, g, S, E, F.wave);
    } else {
        pg8::EpiPle E{ka->out, (const pg8::bf16_t*)(ws + WS_XN)};
        pg8::gemm_phase<pg8::EpiPle, pg8::StaticOrder, true, true>(F.lds + RING_OFF, g, S, E, F.wave);
    }
}

#define XB_TMO      128
#define XB_XCNT(j)  (256  + 64 * (j))
#define XB_XSUB(j)  (1280 + 64 * (j))
#define XB_XGEN(j)  (2304 + 64 * (j))
#define XB_TOP      3328
#define XB_TOPGEN   3392
#define XCD_BAR_WORDS 3456
#define XB_SPIN_CAP (1u << 18)

__device__ __forceinline__ unsigned xb_ld(unsigned* p)              { return __hip_atomic_load(p, __ATOMIC_RELAXED, __HIP_MEMORY_SCOPE_AGENT); }
__device__ __forceinline__ unsigned xb_add(unsigned* p, unsigned v) { return __hip_atomic_fetch_add(p, v, __ATOMIC_RELAXED, __HIP_MEMORY_SCOPE_AGENT); }
__device__ __forceinline__ unsigned xb_xcc_id() { return (unsigned)__builtin_amdgcn_s_getreg((3 << 11) | 20) & 0xFu; }
#define XB_SPIN(cond, bar) do { unsigned _sp = 0; while (cond) { __builtin_amdgcn_s_sleep(1); \
    if ((++_sp & 255u) == 0u) { if (xb_ld(&(bar)[XB_TMO])) break; if (_sp > XB_SPIN_CAP) { atomicAdd(&(bar)[XB_TMO], 1u); break; } } } } while (0)

struct XcdBarrier {
    unsigned* bar; unsigned x;
    volatile LAS unsigned* st;
};

__device__ __forceinline__ XcdBarrier xcd_barrier_post(unsigned* bar, volatile LAS unsigned* st) {
    XcdBarrier b; b.bar = bar; b.x = xb_xcc_id(); b.st = st;
    if (threadIdx.x == 0) (void)xb_add(&bar[XB_XCNT(b.x)], 1u);
    return b;
}
__device__ __forceinline__ void xcd_barrier_complete(unsigned* bar, unsigned x, unsigned& nloc, unsigned& nx) {
    const unsigned G = gridDim.x * gridDim.y * gridDim.z;
    unsigned sum, cnt, mine, sp = 0u;
    for (;;) {
        sum = 0u; cnt = 0u; mine = 0u;
#pragma unroll
        for (unsigned j = 0; j < 16; ++j) { const unsigned c = xb_ld(&bar[XB_XCNT(j)]); sum += c; cnt += (c > 0u) ? 1u : 0u; mine = (j == x) ? c : mine; }
        if (sum == G) break;
        __builtin_amdgcn_s_sleep(1);
        if ((++sp & 255u) == 0u) { if (xb_ld(&bar[XB_TMO])) break; if (sp > XB_SPIN_CAP) { atomicAdd(&bar[XB_TMO], 1u); break; } }
    }
    nloc = mine > 0u ? mine : 1u; nx = cnt > 0u ? cnt : 1u;
}

__device__ __forceinline__ void xcd_barrier(const XcdBarrier& b) {
    asm volatile("s_waitcnt vmcnt(0)" ::: "memory");
    __syncthreads();
    if (threadIdx.x == 0) {
        unsigned* bar = b.bar;
        __builtin_amdgcn_s_waitcnt(0);
        unsigned nloc = b.st[0], nx = b.st[1];
        if (nloc == 0u) { xcd_barrier_complete(bar, b.x, nloc, nx); b.st[0] = nloc; b.st[1] = nx; }
        const unsigned old = xb_add(&bar[XB_XSUB(b.x)], 1u);
        const unsigned gen = old / nloc;
        if (old + 1u == (gen + 1u) * nloc) {
            __builtin_amdgcn_fence(__ATOMIC_RELEASE, "agent");
            asm volatile("s_waitcnt vmcnt(0)" ::: "memory");
            const unsigned og = xb_add(&bar[XB_TOP], 1u);
            const unsigned tg = og / nx;
            if (og + 1u == (tg + 1u) * nx) xb_add(&bar[XB_TOPGEN], 1u);
            else XB_SPIN(xb_ld(&bar[XB_TOPGEN]) == tg, bar);
            __builtin_amdgcn_fence(__ATOMIC_ACQUIRE, "agent");
            xb_add(&bar[XB_XGEN(b.x)], 1u);
            asm volatile("s_waitcnt vmcnt(0)" ::: "memory");
        } else {
            XB_SPIN(xb_ld(&bar[XB_XGEN(b.x)]) == gen, bar);
            __builtin_amdgcn_fence(__ATOMIC_ACQUIRE, "agent");
            asm volatile("s_waitcnt vmcnt(0)" ::: "memory");
        }
    }
    __syncthreads();
}
__device__ __forceinline__ void grid_bar(unsigned char* ldsp) {
    XcdBarrier b; b.bar = (unsigned*)(kargs_ptr()->ws + WS_CTL) + CW_BAR; b.x = xb_xcc_id(); b.st = (volatile LAS unsigned*)((LAS unsigned char*)ldsp + MISC_OFF) + 8;
    xcd_barrier(b);
}
__device__ __forceinline__ void xcc_bar(unsigned char* ldsp) {
    asm volatile("s_waitcnt vmcnt(0)" ::: "memory");
    __syncthreads();
    if (threadIdx.x == 0) {
        unsigned* ctl = (unsigned*)(kargs_ptr()->ws + WS_CTL); const unsigned x = xb_xcc_id();
        __builtin_amdgcn_s_waitcnt(0);
        const unsigned old = xb_add(&ctl[CW_LOC + 64 * x], 1u), gen = old / 32u;
        if (old + 1u == (gen + 1u) * 32u) xb_add(&ctl[CW_LOC + 1024 + 64 * x], 1u);
        else { unsigned sp = 0; while (xb_ld(&ctl[CW_LOC + 1024 + 64 * x]) == gen) { __builtin_amdgcn_s_sleep(1); if (++sp > (1u << 22)) break; } }
        __builtin_amdgcn_fence(__ATOMIC_ACQUIRE, "agent");
        asm volatile("s_waitcnt vmcnt(0)" ::: "memory");
    }
    __syncthreads();
}
__device__ __forceinline__ void xcc_mode_setup(unsigned char* ldsp) {
    volatile LAS unsigned* MI = (volatile LAS unsigned*)((LAS unsigned char*)ldsp + MISC_OFF);
    if (threadIdx.x == 0) {
        unsigned* bar = (unsigned*)(kargs_ptr()->ws + WS_CTL) + CW_BAR; const unsigned x = xb_xcc_id();
        unsigned npop = 0, xl = 0; bool ok = true;
#pragma unroll
        for (unsigned j = 0; j < 16; ++j) { const unsigned c = xb_ld(&bar[XB_XCNT(j)]); if (c) { ++npop; ok = ok && (c == 32u); if (j < x) ++xl; } }
        const unsigned r = MI[13]; ok = ok && npop == 8u && gridDim.x == 256u && r < 32u;
        MI[10] = ok ? 1u : 0u; MI[11] = 8u * xl + (r & 7u); MI[12] = r >> 3;
    }
    __syncthreads();
}
__global__ void __launch_bounds__(NWAVES * 64, 2) fwd_mega(Args args_unused) {
    extern __shared__ __attribute__((aligned(16))) unsigned char lds[];
    const int wv = __builtin_amdgcn_readfirstlane((int)threadIdx.x >> 6);
    for (int u = threadIdx.x; u < (LDS_BYTES - LDSCTL_OFF) / 4; u += NWAVES * 64) ((LAS unsigned*)((LAS unsigned char*)lds + LDSCTL_OFF))[u] = 0u;
    __syncthreads();
    if (threadIdx.x == 0) { unsigned* bar_ = (unsigned*)(kargs_ptr()->ws + WS_CTL) + CW_BAR; ((volatile LAS unsigned*)((LAS unsigned char*)lds + MISC_OFF))[13] = xb_add(&bar_[XB_XCNT(xb_xcc_id())], 1u); }
#define GRID_BAR() grid_bar(lds)
    p0_prologue(lds, wv);      GRID_BAR();  xcc_mode_setup(lds);
    p1_inproj(lds, wv);        GRID_BAR();
    p2_pre(lds, wv); p2_attention(lds, wv);     GRID_BAR();
    p3_combine(lds, wv);       if (((volatile LAS unsigned*)((LAS unsigned char*)lds + MISC_OFF))[10] != 0u) xcc_bar(lds); else GRID_BAR();
    const bool xmode = ((volatile LAS unsigned*)((LAS unsigned char*)lds + MISC_OFF))[10] != 0u;
    const bool late_ple = xmode && ((((volatile LAS unsigned*)((LAS unsigned char*)lds + MISC_OFF))[11] >> 3) & 1u) != 0u;
    if (!late_ple) p4a_ple(lds, wv);
    p4b_branches(lds, wv);     if (xmode) xcc_bar(lds); else GRID_BAR();
    p5_out(lds, wv);           if (xmode) xcc_bar(lds); else GRID_BAR();
    if (late_ple) p4a_ple(lds, wv);
    p6_ple(lds, wv);
    if (gridDim.x != 256) { GRID_BAR(); p7_final(lds, wv); }
}

extern "C" void kernel_launch(void* const* d_in, const int* in_sizes, int n_in, void* d_out, int out_size, void* d_ws, size_t ws_size, hipStream_t stream) {
    static int grid = 0;
    if (grid == 0) {
        if (n_in != 15 || in_sizes[0] != M * D || out_size != M * D || ws_size < WS_END) { fprintf(stderr, "kernel_launch: unexpected shapes (n_in %d, in0 %d, out %d, ws %zu)\n", n_in, n_in > 0 ? in_sizes[0] : -1, out_size, ws_size); grid = -1; return; }
        int dev = 0, cus = 0, per_cu = 0;
        if (hipGetDevice(&dev) != hipSuccess || hipDeviceGetAttribute(&cus, hipDeviceAttributeMultiprocessorCount, dev) != hipSuccess) { grid = -1; return; }
        if (hipFuncSetAttribute((const void*)fwd_mega, hipFuncAttributeMaxDynamicSharedMemorySize, LDS_BYTES) != hipSuccess) { fprintf(stderr, "kernel_launch: hipFuncSetAttribute failed\n"); grid = -1; return; }
        if (hipOccupancyMaxActiveBlocksPerMultiprocessor(&per_cu, (const void*)fwd_mega, NWAVES * 64, LDS_BYTES) != hipSuccess || per_cu < 1) { fprintf(stderr, "kernel_launch: occupancy query says %d\n", per_cu); per_cu = 1; }
        (void)hipGetLastError();
        grid = cus * per_cu;
    }
    if (grid < 0) return;
    if (hipMemsetAsync((char*)d_ws + WS_CTL, 0, 65536, stream) != hipSuccess) { fprintf(stderr, "kernel_launch: memset failed\n"); return; }
    Args a{};
    for (int i = 0; i < 15; ++i) a.in[i] = (const float*)d_in[i];
    a.out = (float*)d_out; a.ws = (unsigned char*)d_ws;
    void* kargs[] = {&a};
    hipError_t e = hipLaunchCooperativeKernel((const void*)fwd_mega, dim3(grid), dim3(NWAVES * 64), kargs, LDS_BYTES, stream);
    if (e != hipSuccess) fprintf(stderr, "cooperative launch failed: %s (grid %d)\n", hipGetErrorString(e), grid);
}
```
